# Optimizing an MI355X kernel written in HIP

```python
import math
import jax, jax.numpy as jnp
from jax import lax
import numpy as np

D_MODEL = 1024
BATCH = 32
SEQ = 2048
DEPTH = 1

CHUNK = 64
Q_BLOCK = 128
N_HEADS_A = 8
NOPE_DIM = 64
ROPE_DIM = 32
V_DIM_A = 64
Q_LORA = 384
KV_LORA = 256
N_HEADS_B = 8
HEAD_DIM_B = 64
WIDTH_A = N_HEADS_A * V_DIM_A
WIDTH_B = N_HEADS_B * HEAD_DIM_B
ROPE_THETA = 10000.0
EPS = 1e-6
SPLITS = (Q_LORA, KV_LORA, ROPE_DIM, WIDTH_A, WIDTH_B, WIDTH_B, WIDTH_B,
          N_HEADS_B, WIDTH_B, D_MODEL, D_MODEL)
D_IN = sum(SPLITS)

kernel_name = "hybrid_mla_fox_gated_block"


def rms_norm(x, w):
    xf = x.astype(jnp.float32)
    y = xf * lax.rsqrt(jnp.mean(xf * xf, axis=-1, keepdims=True) + EPS)
    return (y * w.astype(jnp.float32)).astype(x.dtype)


def rope_angles(positions):
    inv_freq = ROPE_THETA ** (-jnp.arange(0, ROPE_DIM, 2, dtype=jnp.float32) / ROPE_DIM)
    ang = positions.astype(jnp.float32)[..., None] * inv_freq
    return jnp.cos(ang), jnp.sin(ang)


def apply_rope(x, cos, sin):
    x1, x2 = jnp.split(x.astype(jnp.float32), 2, axis=-1)
    y = jnp.concatenate([x1 * cos - x2 * sin, x2 * cos + x1 * sin], axis=-1)
    return y.astype(x.dtype)


def chunk_causal_mask(lo, hi):
    qp = lo + jnp.arange(Q_BLOCK)
    kp = jnp.arange(hi)
    return (kp[None, :] // CHUNK) <= (qp[:, None] // CHUNK)


def mla_attention(q_nope, q_rope, k_nope, k_rope, v):
    seq = q_nope.shape[1]
    scale = 1.0 / math.sqrt(NOPE_DIM + ROPE_DIM)
    outs = []
    for i in range(seq // Q_BLOCK):
        lo, hi = i * Q_BLOCK, (i + 1) * Q_BLOCK
        s = (jnp.einsum('bqhd,bkhd->bhqk', q_nope[:, lo:hi], k_nope[:, :hi],
                        preferred_element_type=jnp.float32)
             + jnp.einsum('bqhr,bkr->bhqk', q_rope[:, lo:hi], k_rope[:, :hi],
                          preferred_element_type=jnp.float32)) * scale
        s = jnp.where(chunk_causal_mask(lo, hi), s, -jnp.inf)
        p = jax.nn.softmax(s, axis=-1).astype(v.dtype)
        outs.append(jnp.einsum('bhqk,bkhd->bqhd', p, v[:, :hi]))
    return jnp.concatenate(outs, axis=1)


def fox_attention(q, k, v, log_f):
    seq = q.shape[1]
    scale = 1.0 / math.sqrt(HEAD_DIM_B)
    cum = jnp.swapaxes(jnp.cumsum(log_f, axis=1), 1, 2)
    outs = []
    for i in range(seq // Q_BLOCK):
        lo, hi = i * Q_BLOCK, (i + 1) * Q_BLOCK
        s = jnp.einsum('bqhd,bkhd->bhqk', q[:, lo:hi], k[:, :hi],
                       preferred_element_type=jnp.float32) * scale
        s = s + (cum[:, :, lo:hi, None] - cum[:, :, None, :hi])
        qp = lo + jnp.arange(Q_BLOCK)
        kp = jnp.arange(hi)
        s = jnp.where(kp[None, :] <= qp[:, None], s, -jnp.inf)
        p = jax.nn.softmax(s, axis=-1).astype(v.dtype)
        outs.append(jnp.einsum('bhqk,bkhd->bqhd', p, v[:, :hi]))
    return jnp.concatenate(outs, axis=1)


def setup_inputs(seed: int = 0) -> dict:
    key = jax.random.key(seed)
    ks = jax.random.split(key, 24)
    f32 = jnp.float32
    nrm = lambda k, shape, s: jax.random.normal(k, shape, f32) * s
    gain = lambda k, n: 1.0 + 0.05 * jax.random.normal(k, (DEPTH, n), f32)
    x = jax.random.normal(ks[0], (BATCH, SEQ, D_MODEL), f32)
    c = jax.random.normal(ks[1], (BATCH, D_MODEL), f32)
    offset = jax.random.randint(ks[2], (BATCH, 1), 0, 4096, dtype=jnp.int32)
    positions = offset + jnp.arange(SEQ, dtype=jnp.int32)[None, :]
    return {
        "x": x,
        "c": c,
        "positions": positions,
        "w_ada": nrm(ks[3], (DEPTH, D_MODEL, 3 * D_MODEL), 0.5 * D_MODEL ** -0.5),
        "b_ada": nrm(ks[4], (DEPTH, 3 * D_MODEL), 0.02),
        "norm_w": gain(ks[5], D_MODEL),
        "w_in": nrm(ks[6], (DEPTH, D_MODEL, D_IN), D_MODEL ** -0.5),
        "b_f": jax.random.uniform(ks[7], (DEPTH, N_HEADS_B), f32, 1.0, 5.0),
        "q_lora_norm_w": gain(ks[8], Q_LORA),
        "kv_lora_norm_w": gain(ks[9], KV_LORA),
        "w_uq": nrm(ks[10], (DEPTH, Q_LORA, N_HEADS_A * (NOPE_DIM + ROPE_DIM)), Q_LORA ** -0.5),
        "w_ukv": nrm(ks[11], (DEPTH, KV_LORA, N_HEADS_A * (NOPE_DIM + V_DIM_A)), KV_LORA ** -0.5),
        "qn_nope_a": gain(ks[12], NOPE_DIM),
        "qn_rope_a": gain(ks[13], ROPE_DIM),
        "kn_nope_a": gain(ks[14], NOPE_DIM),
        "kn_rope_a": gain(ks[15], ROPE_DIM),
        "qn_b": gain(ks[16], HEAD_DIM_B),
        "kn_b": gain(ks[17], HEAD_DIM_B),
        "w_branch_a": nrm(ks[18], (DEPTH, WIDTH_A, D_MODEL), WIDTH_A ** -0.5),
        "w_branch_b": nrm(ks[19], (DEPTH, WIDTH_B, D_MODEL), WIDTH_B ** -0.5),
        "w_out": nrm(ks[20], (DEPTH, D_MODEL, D_MODEL), D_MODEL ** -0.5),
    }


def reference(x, c, positions, w_ada, b_ada, norm_w, w_in, b_f, q_lora_norm_w,
              kv_lora_norm_w, w_uq, w_ukv, qn_nope_a, qn_rope_a, kn_nope_a,
              kn_rope_a, qn_b, kn_b, w_branch_a, w_branch_b, w_out):
    B, S, _ = x.shape
    cos, sin = rope_angles(positions)
    split_points = np.cumsum(SPLITS)[:-1].tolist()
    for l in range(DEPTH):
        ada = c @ w_ada[l] + b_ada[l]
        shift, scale, gate = jnp.split(ada, 3, axis=-1)
        h = rms_norm(x, norm_w[l]) * (1.0 + scale[:, None, :]) + shift[:, None, :]

        proj = h @ w_in[l]
        (cq, ckv, k_rope, gate_a, q_b, k_b, v_b, f_b, gate_b,
         mg_a, mg_b) = jnp.split(proj, split_points, axis=-1)

        q = (rms_norm(cq, q_lora_norm_w[l]) @ w_uq[l]).reshape(B, S, N_HEADS_A, NOPE_DIM + ROPE_DIM)
        q_nope, q_rope = q[..., :NOPE_DIM], q[..., NOPE_DIM:]
        kv = (rms_norm(ckv, kv_lora_norm_w[l]) @ w_ukv[l]).reshape(B, S, N_HEADS_A, NOPE_DIM + V_DIM_A)
        k_nope, v_a = kv[..., :NOPE_DIM], kv[..., NOPE_DIM:]
        q_nope = rms_norm(q_nope, qn_nope_a[l])
        q_rope = apply_rope(rms_norm(q_rope, qn_rope_a[l]), cos[:, :, None, :], sin[:, :, None, :])
        k_nope = rms_norm(k_nope, kn_nope_a[l])
        k_rope = apply_rope(rms_norm(k_rope, kn_rope_a[l]), cos, sin)
        o_a = mla_attention(q_nope, q_rope, k_nope, k_rope, v_a).reshape(B, S, WIDTH_A)
        y_a = o_a * jax.nn.silu(gate_a)

        qb = rms_norm(q_b.reshape(B, S, N_HEADS_B, HEAD_DIM_B), qn_b[l])
        kb = rms_norm(k_b.reshape(B, S, N_HEADS_B, HEAD_DIM_B), kn_b[l])
        vb = v_b.reshape(B, S, N_HEADS_B, HEAD_DIM_B)
        log_f = jax.nn.log_sigmoid(f_b.astype(jnp.float32) + b_f[l].astype(jnp.float32))
        o_b = fox_attention(qb, kb, vb, log_f).reshape(B, S, WIDTH_B)
        y_b = o_b * jax.nn.silu(gate_b)

        merged = (jax.nn.sigmoid(mg_a) * (y_a @ w_branch_a[l])
                  + jax.nn.sigmoid(mg_b) * (y_b @ w_branch_b[l]))
        x = x + gate[:, None, :] * (merged @ w_out[l])
    return x
```

```cpp
#include <hip/hip_runtime.h>
#include <hip/hip_bf16.h>
#include <cstdio>
#include <cstdint>
#include <cmath>

constexpr int BATCH = 32, SEQ = 2048, DMODEL = 1024, MTOK = BATCH * SEQ;
constexpr int QLORA = 384, KVLORA = 256, ROPE = 32, NH = 8, HD = 64;
constexpr int DIN = 5288, NIN = 5376;
constexpr float EPS = 1e-6f;
constexpr float LOG2E = 1.4426950408889634f;
constexpr float C2B = 0.125f * LOG2E;
constexpr float C2A = 0.10206207261596575f * LOG2E;
constexpr int OC_CQ = 0, OC_CKV = 384, OC_KR = 640, OC_GA = 672, OC_QB = 1184, OC_KB = 1696, OC_VB = 2208, OC_FB = 2720, OC_GB = 2728, OC_MA = 3240, OC_MB = 4264;

constexpr size_t MiB = 1u << 20;
constexpr size_t WSO_CTL = 0, CTL_ZERO_BYTES = 1 * MiB;
constexpr size_t WSO_WIN = 2 * MiB, WSO_WUQ = 13 * MiB, WSO_WUKV = 14 * MiB, WSO_WA = 15 * MiB, WSO_WB = 16 * MiB, WSO_WOUT = 17 * MiB;
constexpr size_t WSO_ADA = 19 * MiB, WSO_COS = 20 * MiB, WSO_SIN = 24 * MiB, WSO_LOGF = 28 * MiB, WSO_SSQQ = 30 * MiB, WSO_SSQKV = 32 * MiB, WSO_KROPE = 34 * MiB, WSO_PAR = 38 * MiB;
constexpr size_t WSO_XN = 40 * MiB;
constexpr size_t WSO_QAN = WSO_XN, WSO_KAN = WSO_XN + 64 * MiB;
constexpr size_t WSO_CQ = 168 * MiB, WSO_CKV = 216 * MiB, WSO_GA = 248 * MiB, WSO_QB = 312 * MiB, WSO_KB = 376 * MiB, WSO_VB = 440 * MiB, WSO_GB = 504 * MiB;
constexpr size_t WSO_MERGED = WSO_KB;
constexpr size_t WSO_SA = 568 * MiB, WSO_SB = 696 * MiB, WSO_QAR = 824 * MiB, WSO_VA = 856 * MiB, WSO_END = 920 * MiB;
static_assert(WSO_WIN + (size_t)NIN * 1024 * 2 <= WSO_WUQ && WSO_SSQKV + (size_t)MTOK * 16 <= WSO_KROPE && WSO_KROPE + (size_t)MTOK * 64 <= WSO_PAR, "d_ws map");
constexpr int PAR_QNB = 0, PAR_KNB = 64, PAR_KNROPE = 128, PAR_BF = 160, PAR_QNNOPE = 192, PAR_QNROPE = 256, PAR_KNNOPE = 320, PAR_N = 384;

namespace pg8 {
#define PG8_LAS __attribute__((address_space(3)))
typedef unsigned short bf16_t;
typedef short bf16x8 __attribute__((ext_vector_type(8)));
typedef float f32x4 __attribute__((ext_vector_type(4)));
typedef unsigned u32x4 __attribute__((ext_vector_type(4)));
constexpr int BM = 256, BK = 64, HALF = 128, HTB = HALF * BK * 2  , STAGE_BYTES = 8 * HTB, NXCD = 8, WGM = 8;

__host__ __device__ __forceinline__ int lds_byte(int r, int c) { const int st = (r >> 4) * 2 + (c >> 5), rr = r & 15, cc = c & 31, ob = rr * 64 + cc * 2; return st * 1024 + (ob ^ (((ob >> 9) & 1) << 5)); }
__host__ __device__ __forceinline__ void stage_rc(int b, int& R, int& C) { const int st = b / 1024, sb = b % 1024, swz = sb ^ (((sb >> 9) & 1) << 5); R = (st >> 1) * 16 + swz / 64; C = (st & 1) * 32 + (swz % 64) / 2; }
__host__ __device__ __forceinline__ int perm32(int rho) { const int n = rho >> 4, i = rho & 15; return 8 * (i >> 2) + 4 * n + (i & 3); }

struct Unit { int pm, pn; };
struct Gemm { const bf16_t* A; const bf16_t* Bt; int M, N, K; };

struct StaticOrder {
    int nM, nN, nwg, G, c;
    __host__ __device__ void init(int M, int N, int G_, int c_) { nM = M / BM; nN = N / BM; nwg = nM * nN; G = G_; c = c_; }
    __host__ __device__ bool next(int i, Unit& u) const {
        const long L = (long)i * G + c; if (L >= nwg) return false;
        int wgid = (int)L; { const int q = nwg / NXCD, r = nwg % NXCD, xcd = wgid % NXCD, off = wgid / NXCD; wgid = (xcd < r ? xcd * (q + 1) : r * (q + 1) + (xcd - r) * q) + off; }
        const int nig = WGM * nN, gid = wgid / nig, fm = gid * WGM, gsz = (nM - fm) < WGM ? (nM - fm) : WGM;
        u.pm = fm + ((wgid % nig) % gsz); u.pn = (wgid % nig) / gsz; return true;
    }
    __device__ __forceinline__ void a_ready(const Unit&) const {}
    __device__ __forceinline__ void done(const Unit&) const {}
};

__device__ __forceinline__ unsigned cvt_pk_bf16(float lo, float hi) { unsigned r; asm volatile("v_cvt_pk_bf16_f32 %0, %1, %2" : "=v"(r) : "v"(lo), "v"(hi)); return r; }
typedef float f32x2 __attribute__((ext_vector_type(2)));
__device__ __forceinline__ int lane_id_asm() { int l; asm volatile("v_mbcnt_lo_u32_b32 %0, -1, 0\n\tv_mbcnt_hi_u32_b32 %0, -1, %0" : "=v"(l)); return l; }

__device__ __forceinline__ float silu_f(float z) { return z * __builtin_amdgcn_rcpf(1.f + __expf(-z)); }
__device__ __forceinline__ float sigm_f(float z) { return __builtin_amdgcn_rcpf(1.f + __expf(-z)); }
__device__ __forceinline__ u32x4 pack8(const f32x4 a, const f32x4 b) { u32x4 w; w.x = cvt_pk_bf16(a[0], a[1]); w.y = cvt_pk_bf16(a[2], a[3]); w.z = cvt_pk_bf16(b[0], b[1]); w.w = cvt_pk_bf16(b[2], b[3]); return w; }
__device__ __forceinline__ float bf_lo(unsigned u) { return __uint_as_float(u << 16); }
__device__ __forceinline__ float bf_hi(unsigned u) { return __uint_as_float(u & 0xffff0000u); }
__device__ __forceinline__ float sq4(const f32x4 x) { return (x[0] * x[0] + x[1] * x[1]) + (x[2] * x[2] + x[3] * x[3]); }
__device__ __forceinline__ float red_fq(float s) { s += __shfl_xor(s, 16); s += __shfl_xor(s, 32); return s; }

template <int ACT> __device__ __forceinline__ void epi_plain(const f32x4 (&acc)[2][2][4][2], int row0, int wc, int fq, bf16_t* dst, int ldc, int col_base) {
#pragma unroll
    for (int ai = 0; ai < 2; ++ai)
#pragma unroll
        for (int m = 0; m < 4; ++m) { bf16_t* rowp = dst + (size_t)(row0 + ai * HALF + m * 16) * ldc + col_base + wc * 32 + 8 * fq;
#pragma unroll
            for (int bj = 0; bj < 2; ++bj) { f32x4 v0 = acc[ai][bj][m][0], v1 = acc[ai][bj][m][1];
                if (ACT == 1) {
#pragma unroll
                    for (int e = 0; e < 4; ++e) { v0[e] = silu_f(v0[e]); v1[e] = silu_f(v1[e]); } }
                if (ACT == 2) {
#pragma unroll
                    for (int e = 0; e < 4; ++e) { v0[e] = sigm_f(v0[e]); v1[e] = sigm_f(v1[e]); } }
                *(u32x4*)(rowp + bj * HALF) = pack8(v0, v1); } }
}
template <int NBJ> __device__ __forceinline__ void epi_ssq(const f32x4 (&acc)[2][2][4][2], int row0, int fq, float* ssq, int ld, int slot) {
#pragma unroll
    for (int ai = 0; ai < 2; ++ai)
#pragma unroll
        for (int m = 0; m < 4; ++m) { float s = 0.f;
#pragma unroll
            for (int bj = 0; bj < NBJ; ++bj) s += sq4(acc[ai][bj][m][0]) + sq4(acc[ai][bj][m][1]);
            s = red_fq(s);
            if (fq == 0) ssq[(size_t)(row0 + ai * HALF + m * 16) * ld + slot] = s; }
}
template <int NSLOT> __device__ __forceinline__ float row_rs(const float* ssq, int row, float inv_n) { const float* p = ssq + (size_t)row * NSLOT; float s = 0.f;
#pragma unroll
    for (int k = 0; k < NSLOT; k += 4) { const f32x4 v = *(const f32x4*)(p + k); s += (v[0] + v[1]) + (v[2] + v[3]); }
    return rsqrtf(s * inv_n + EPS); }
template <int NSLOT> __device__ __forceinline__ void epi_heads(const f32x4 (&acc)[2][2][4][2], int row0, int wc, int fq, bf16_t* dst, int ldc, int head0, const float* w, float wscale, const float* ssq, float inv_n) {
    f32x4 wv[2][2];
#pragma unroll
    for (int bj = 0; bj < 2; ++bj)
#pragma unroll
        for (int n = 0; n < 2; ++n) wv[bj][n] = *(const f32x4*)(w + 32 * bj + 8 * fq + 4 * n) * wscale;
#pragma unroll
    for (int ai = 0; ai < 2; ++ai)
#pragma unroll
        for (int m = 0; m < 4; ++m) { float s = 0.f;
#pragma unroll
            for (int bj = 0; bj < 2; ++bj) s += sq4(acc[ai][bj][m][0]) + sq4(acc[ai][bj][m][1]);
            s = red_fq(s);
            const float r = NSLOT ? row_rs<NSLOT ? NSLOT : 4>(ssq, row0 + ai * HALF + m * 16, inv_n) : 1.f;
            const float f = r * rsqrtf(s * r * r * (1.f / 64.f) + EPS);
            bf16_t* rowp = dst + (size_t)(row0 + ai * HALF + m * 16) * ldc + (head0 + wc) * 64 + 8 * fq;
#pragma unroll
            for (int bj = 0; bj < 2; ++bj) *(u32x4*)(rowp + 32 * bj) = pack8(acc[ai][bj][m][0] * f * wv[bj][0], acc[ai][bj][m][1] * f * wv[bj][1]);
            asm volatile("" ::: "memory"); }
}
__device__ __forceinline__ void rope_group(const f32x4 x0, const f32x4 x1, float r, const f32x4 w0, const f32x4 w1, const float* cosr, const float* sinr, int fq, float oscale, bf16_t* outp) {
    float s = red_fq(sq4(x0) + sq4(x1));
    const float f = r * rsqrtf(s * r * r * (1.f / 32.f) + EPS);
    const f32x4 y0 = x0 * f * w0, y1 = x1 * f * w1;
    f32x4 p0, p1;
#pragma unroll
    for (int e = 0; e < 4; ++e) { p0[e] = __shfl_xor(y0[e], 32); p1[e] = __shfl_xor(y1[e], 32); }
    const int i0 = 8 * (fq & 1);
    const f32x4 c0 = *(const f32x4*)(cosr + i0), c1 = *(const f32x4*)(cosr + i0 + 4), s0 = *(const f32x4*)(sinr + i0), s1 = *(const f32x4*)(sinr + i0 + 4);
    const float sg = (fq < 2) ? -oscale : oscale;
    const f32x4 o0 = y0 * c0 * oscale + p0 * s0 * sg, o1 = y1 * c1 * oscale + p1 * s1 * sg;
    *(u32x4*)outp = pack8(o0, o1);
    asm volatile("" ::: "memory");
}

struct EpiIn {
    static constexpr bool PERM = true, AFTER_DRAIN = false;
    unsigned char* ws;
    __device__ __forceinline__ void operator()(const f32x4 (&acc)[2][2][4][2], const Unit& u, int wr, int wc, int fr, int fq) const {
        { const int l_ = lane_id_asm(); fr = l_ & 15; fq = l_ >> 4; }
        const int pn = u.pn, row0 = u.pm * BM + wr * 64 + fr;
        unsigned char* w_ = ws; asm volatile("" : "+s"(w_));
        bf16_t *QB = (bf16_t*)(w_ + WSO_QB), *KB = (bf16_t*)(w_ + WSO_KB), *VB = (bf16_t*)(w_ + WSO_VB), *GA = (bf16_t*)(w_ + WSO_GA), *GB = (bf16_t*)(w_ + WSO_GB), *SA = (bf16_t*)(w_ + WSO_SA), *SB = (bf16_t*)(w_ + WSO_SB),
               *CKV = (bf16_t*)(w_ + WSO_CKV), *CQ = (bf16_t*)(w_ + WSO_CQ), *KROPE = (bf16_t*)(w_ + WSO_KROPE);
        float *LOGF = (float*)(w_ + WSO_LOGF), *SSQ_Q = (float*)(w_ + WSO_SSQQ), *SSQ_KV = (float*)(w_ + WSO_SSQKV);
        const float *PAR = (const float*)(w_ + WSO_PAR), *qn_b = PAR + PAR_QNB, *kn_b = PAR + PAR_KNB, *kn_rope = PAR + PAR_KNROPE, *b_f = PAR + PAR_BF, *COS = (const float*)(w_ + WSO_COS), *SIN = (const float*)(w_ + WSO_SIN);
        if (pn < 2) epi_heads<0>(acc, row0, wc, fq, QB, 512, pn * 4, qn_b, C2B, nullptr, 0.f);
        else if (pn < 4) epi_heads<0>(acc, row0, wc, fq, KB, 512, (pn - 2) * 4, kn_b, 1.f, nullptr, 0.f);
        else if (pn < 6) epi_plain<0>(acc, row0, wc, fq, VB, 512, (pn - 4) * 256);
        else if (pn < 8) epi_plain<1>(acc, row0, wc, fq, GA, 512, (pn - 6) * 256);
        else if (pn < 10) epi_plain<1>(acc, row0, wc, fq, GB, 512, (pn - 8) * 256);
        else if (pn < 14) epi_plain<2>(acc, row0, wc, fq, SA, 1024, (pn - 10) * 256);
        else if (pn < 18) epi_plain<2>(acc, row0, wc, fq, SB, 1024, (pn - 14) * 256);
        else if (pn == 18) { epi_plain<0>(acc, row0, wc, fq, CKV, 256, 0); epi_ssq<2>(acc, row0, fq, SSQ_KV, 4, wc); }
        else if (pn == 19) { epi_plain<0>(acc, row0, wc, fq, CQ, 384, 0); epi_ssq<2>(acc, row0, fq, SSQ_Q, 8, wc); }
        else {
            epi_ssq<1>(acc, row0, fq, SSQ_Q, 8, 4 + wc);
#pragma unroll
            for (int ai = 0; ai < 2; ++ai)
#pragma unroll
                for (int m = 0; m < 4; ++m) *(u32x4*)(CQ + (size_t)(row0 + ai * HALF + m * 16) * 384 + 256 + wc * 32 + 8 * fq) = pack8(acc[ai][0][m][0], acc[ai][0][m][1]);
            if (wc == 0) {
                const f32x4 w0 = *(const f32x4*)(kn_rope + 8 * fq), w1 = *(const f32x4*)(kn_rope + 8 * fq + 4);
#pragma unroll
                for (int ai = 0; ai < 2; ++ai)
#pragma unroll
                    for (int m = 0; m < 4; ++m) { const size_t row = (size_t)(row0 + ai * HALF + m * 16);
                        rope_group(acc[ai][1][m][0], acc[ai][1][m][1], 1.f, w0, w1, COS + row * 16, SIN + row * 16, fq, 1.f, KROPE + row * 32 + 8 * fq); }
            } else if (wc == 1) {
                if (fq == 0) { const f32x4 b0 = *(const f32x4*)(b_f), b1 = *(const f32x4*)(b_f + 4);
#pragma unroll
                    for (int ai = 0; ai < 2; ++ai)
#pragma unroll
                        for (int m = 0; m < 4; ++m) { const size_t row = (size_t)(row0 + ai * HALF + m * 16); f32x4 z0 = acc[ai][1][m][0] + b0, z1 = acc[ai][1][m][1] + b1;
#pragma unroll
                            for (int e = 0; e < 4; ++e) { z0[e] = fminf(z0[e], 0.f) - log1pf(expf(-fabsf(z0[e]))); z1[e] = fminf(z1[e], 0.f) - log1pf(expf(-fabsf(z1[e]))); }
                            *(f32x4*)(LOGF + row * 8) = z0; *(f32x4*)(LOGF + row * 8 + 4) = z1; } }
            }
        }
    }
};
struct EpiQup {
    static constexpr bool PERM = true, AFTER_DRAIN = false;
    unsigned char* ws;
    __device__ __forceinline__ void operator()(const f32x4 (&acc)[2][2][4][2], const Unit& u, int wr, int wc, int fr, int fq) const {
        { const int l_ = lane_id_asm(); fr = l_ & 15; fq = l_ >> 4; }
        const int pn = u.pn, row0 = u.pm * BM + wr * 64 + fr;
        unsigned char* w_ = ws; asm volatile("" : "+s"(w_));
        bf16_t *QAN = (bf16_t*)(w_ + WSO_QAN), *QAR = (bf16_t*)(w_ + WSO_QAR);
        const float *SSQ_Q = (const float*)(w_ + WSO_SSQQ), *PAR = (const float*)(w_ + WSO_PAR), *qn_nope = PAR + PAR_QNNOPE, *qn_rope = PAR + PAR_QNROPE, *COS = (const float*)(w_ + WSO_COS), *SIN = (const float*)(w_ + WSO_SIN);
        if (pn < 2) epi_heads<8>(acc, row0, wc, fq, QAN, 512, pn * 4, qn_nope, C2A, SSQ_Q, 1.f / 384.f);
        else { const f32x4 w0 = *(const f32x4*)(qn_rope + 8 * fq), w1 = *(const f32x4*)(qn_rope + 8 * fq + 4);
#pragma unroll
            for (int ai = 0; ai < 2; ++ai)
#pragma unroll
                for (int m = 0; m < 4; ++m) { const size_t row = (size_t)(row0 + ai * HALF + m * 16); const float rsr = row_rs<8>(SSQ_Q, (int)row, 1.f / 384.f);
#pragma unroll
                    for (int bj = 0; bj < 2; ++bj) rope_group(acc[ai][bj][m][0], acc[ai][bj][m][1], rsr, w0, w1, COS + row * 16, SIN + row * 16, fq, C2A, QAR + row * 256 + (4 * bj + wc) * 32 + 8 * fq); } }
    }
};
struct EpiKVup {
    static constexpr bool PERM = true, AFTER_DRAIN = false;
    unsigned char* ws;
    __device__ __forceinline__ void operator()(const f32x4 (&acc)[2][2][4][2], const Unit& u, int wr, int wc, int fr, int fq) const {
        { const int l_ = lane_id_asm(); fr = l_ & 15; fq = l_ >> 4; }
        const int pn = u.pn, row0 = u.pm * BM + wr * 64 + fr;
        unsigned char* w_ = ws; asm volatile("" : "+s"(w_));
        bf16_t *KAN = (bf16_t*)(w_ + WSO_KAN), *VA = (bf16_t*)(w_ + WSO_VA);
        const float *SSQ_KV = (const float*)(w_ + WSO_SSQKV), *kn_nope = (const float*)(w_ + WSO_PAR) + PAR_KNNOPE;
        if (pn < 2) epi_heads<4>(acc, row0, wc, fq, KAN, 512, pn * 4, kn_nope, 1.f, SSQ_KV, 1.f / 256.f);
        else {
#pragma unroll
            for (int ai = 0; ai < 2; ++ai)
#pragma unroll
                for (int m = 0; m < 4; ++m) { bf16_t* rowp = VA + (size_t)(row0 + ai * HALF + m * 16) * 512 + (pn - 2) * 256 + wc * 32 + 8 * fq; const float r = row_rs<4>(SSQ_KV, row0 + ai * HALF + m * 16, 1.f / 256.f);
#pragma unroll
                    for (int bj = 0; bj < 2; ++bj) *(u32x4*)(rowp + bj * HALF) = pack8(acc[ai][bj][m][0] * r, acc[ai][bj][m][1] * r);
                    asm volatile("" ::: "memory"); } }
    }
};
template <bool SECOND> struct EpiBranch {
    static constexpr bool PERM = true, AFTER_DRAIN = false;
    const bf16_t* S; bf16_t* T;
    __device__ __forceinline__ void operator()(const f32x4 (&acc)[2][2][4][2], const Unit& u, int wr, int wc, int fr, int fq) const {
        { const int l_ = lane_id_asm(); fr = l_ & 15; fq = l_ >> 4; }
        const int row0 = u.pm * BM + wr * 64 + fr, col0 = u.pn * BM + wc * 32 + 8 * fq;
#pragma unroll
        for (int ai = 0; ai < 2; ++ai)
#pragma unroll
            for (int m = 0; m < 4; ++m) { const size_t off = (size_t)(row0 + ai * HALF + m * 16) * 1024 + col0;
#pragma unroll
                for (int bj = 0; bj < 2; ++bj) { const u32x4 s = *(const u32x4*)(S + off + bj * HALF); f32x4 v0 = acc[ai][bj][m][0], v1 = acc[ai][bj][m][1];
                    v0[0] *= bf_lo(s.x); v0[1] *= bf_hi(s.x); v0[2] *= bf_lo(s.y); v0[3] *= bf_hi(s.y); v1[0] *= bf_lo(s.z); v1[1] *= bf_hi(s.z); v1[2] *= bf_lo(s.w); v1[3] *= bf_hi(s.w);
                    if (SECOND) { const u32x4 t = *(const u32x4*)(T + off + bj * HALF);
                        v0[0] += bf_lo(t.x); v0[1] += bf_hi(t.x); v0[2] += bf_lo(t.y); v0[3] += bf_hi(t.y); v1[0] += bf_lo(t.z); v1[1] += bf_hi(t.z); v1[2] += bf_lo(t.w); v1[3] += bf_hi(t.w); }
                    *(u32x4*)(T + off + bj * HALF) = pack8(v0, v1); } }
    }
};
struct EpiOut {
    static constexpr bool PERM = false, AFTER_DRAIN = false;
    const float* X; float* O; const float* GATE;
    __device__ __forceinline__ void operator()(const f32x4 (&acc)[2][2][4][2], const Unit& u, int wr, int wc, int fr, int fq) const {
        { const int l_ = lane_id_asm(); fr = l_ & 15; fq = l_ >> 4; }
        const int row0 = u.pm * BM + wr * 64 + fr, col0 = u.pn * BM + wc * 32 + 4 * fq; const float* g = GATE + (size_t)(u.pm >> 3) * 3072 + col0;
        f32x4 gv[2][2];
#pragma unroll
        for (int bj = 0; bj < 2; ++bj)
#pragma unroll
            for (int n = 0; n < 2; ++n) gv[bj][n] = *(const f32x4*)(g + bj * HALF + n * 16);
#pragma unroll
        for (int ai = 0; ai < 2; ++ai)
#pragma unroll
            for (int m = 0; m < 4; ++m) { const size_t off = (size_t)(row0 + ai * HALF + m * 16) * 1024 + col0;
#pragma unroll
                for (int bj = 0; bj < 2; ++bj)
#pragma unroll
                    for (int n = 0; n < 2; ++n) { const f32x4 xv = *(const f32x4*)(X + off + bj * HALF + n * 16); *(f32x4*)(O + off + bj * HALF + n * 16) = xv + gv[bj][n] * acc[ai][bj][m][n]; } }
    }
};

template <class Epi, class Sched, bool ALIGN_EPI = false, bool SP2 = false>
__device__ __forceinline__ void gemm_phase(PG8_LAS unsigned char* lds, const Gemm g, const Sched& S, const Epi& E, int wave_in  ) {
    const int lane = lane_id_asm(), wid = wave_in, tid = wid * 64 + lane,
        wr = wid >> 2, wc = wid & 3, fr = lane & 15, fq = lane >> 4;
    const int K = g.K, nt = K / BK;
    unsigned voffA[2], voffB[2];
#pragma unroll
    for (int i = 0; i < 2; ++i) { int R, C; stage_rc(tid * 16 + i * 8192, R, C); const int Rb = Epi::PERM ? ((R & ~31) + perm32(R & 31)) : R;
        voffA[i] = (unsigned)(R * K + C) * 2u; voffB[i] = (unsigned)(Rb * K + C) * 2u; }
    const size_t kstep = (size_t)(BK * 2);
    const size_t hstep = (size_t)HALF * K * 2;
    const size_t tstep = 2 * hstep;
    const unsigned ldsw = (unsigned)wid * 1024u;
    const int aoff = lds_byte(wr * 64 + fr, fq * 8), boff = lds_byte(wc * 32 + fr, fq * 8);
#define PG8_SA(b, h) (((b) * 2 + (h)) * HTB)
#define PG8_SB(b, h) ((4 + (b) * 2 + (h)) * HTB)
#define PG8_STAGE(bufoff, gbase, voff) do { _Pragma("unroll") for (int _i = 0; _i < 2; ++_i) \
        __builtin_amdgcn_global_load_lds((const unsigned*)((const char*)(gbase) + (voff)[_i]), (PG8_LAS unsigned*)(lds + (bufoff) + ldsw + _i * 8192), 16, 0, 0); } while (0)
#define PG8_LDA(dst, b, h) do { _Pragma("unroll") for (int m = 0; m < 4; ++m) _Pragma("unroll") for (int k = 0; k < 2; ++k) dst[m][k] = *(const PG8_LAS bf16x8*)(lds + PG8_SA(b, h) + aoff + m * 2048 + k * 1024); } while (0)
#define PG8_LDB(dst, b, h) do { _Pragma("unroll") for (int n = 0; n < 2; ++n) _Pragma("unroll") for (int k = 0; k < 2; ++k) dst[n][k] = *(const PG8_LAS bf16x8*)(lds + PG8_SB(b, h) + boff + n * 2048 + k * 1024); } while (0)
#define PG8_MMA(ai, bj, At, Bt) do { __builtin_amdgcn_s_setprio(1); _Pragma("unroll") for (int m = 0; m < 4; ++m) _Pragma("unroll") for (int n = 0; n < 2; ++n) _Pragma("unroll") for (int k = 0; k < 2; ++k) \
        acc[ai][bj][m][n] = __builtin_amdgcn_mfma_f32_16x16x32_bf16(Bt[n][k], At[m][k], acc[ai][bj][m][n], 0, 0, 0); __builtin_amdgcn_s_setprio(0); } while (0)
#define PG8_WAIT_V(n) asm volatile("s_waitcnt vmcnt(" #n ")" ::: "memory")
#define PG8_WAIT_L(n) asm volatile("s_waitcnt lgkmcnt(" #n ")" ::: "memory")
#define PG8_BAR __builtin_amdgcn_s_barrier()
#define PG8_SCHED __builtin_amdgcn_sched_barrier(0)
    Unit cur, nxt; int ui = 0;
    if (!S.next(0, cur)) return;
    f32x4 acc[2][2][4][2];
#pragma unroll
    for (int a = 0; a < 2; ++a)
#pragma unroll
        for (int b = 0; b < 2; ++b)
#pragma unroll
            for (int m = 0; m < 4; ++m)
#pragma unroll
                for (int n = 0; n < 2; ++n) acc[a][b][m][n] = (f32x4){0.f, 0.f, 0.f, 0.f};
    bf16x8 At[4][2], B0[2][2], B1[2][2];
    const char* cA = (const char*)g.A + (size_t)cur.pm * tstep; const char* cB = (const char*)g.Bt + (size_t)cur.pn * tstep;
    S.a_ready(cur);
    if constexpr (SP2) {
        PG8_STAGE(PG8_SB(0, 0), cB, voffB); PG8_STAGE(PG8_SB(0, 1), cB + hstep, voffB); PG8_STAGE(PG8_SA(0, 0), cA, voffA); PG8_STAGE(PG8_SA(0, 1), cA + hstep, voffA);
        if (wr == 1) PG8_BAR;
        PG8_WAIT_V(2); PG8_BAR;
        PG8_STAGE(PG8_SB(1, 0), cB + kstep, voffB); PG8_STAGE(PG8_SA(1, 0), cA + kstep, voffA); PG8_STAGE(PG8_SB(1, 1), cB + hstep + kstep, voffB);
        PG8_WAIT_V(6); PG8_BAR;
    } else {
        PG8_STAGE(PG8_SB(0, 0), cB, voffB); PG8_STAGE(PG8_SA(0, 0), cA, voffA); PG8_STAGE(PG8_SB(0, 1), cB + hstep, voffB); PG8_STAGE(PG8_SA(0, 1), cA + hstep, voffA);
        if (wr == 1) PG8_BAR;
        PG8_WAIT_V(4); PG8_BAR;
        PG8_STAGE(PG8_SB(1, 0), cB + kstep, voffB); PG8_STAGE(PG8_SA(1, 0), cA + kstep, voffA); PG8_STAGE(PG8_SB(1, 1), cB + hstep + kstep, voffB);
        PG8_WAIT_V(6); PG8_BAR;
    }
    for (;;) {
        const bool has_next = S.next(ui + 1, nxt);
        const char* nA = has_next ? (const char*)g.A + (size_t)nxt.pm * tstep : cA; const char* nB = has_next ? (const char*)g.Bt + (size_t)nxt.pn * tstep : cB;
        for (int t = 0; t < nt; t += 2) {
            const bool last = (t == nt - 2);
            const char* a1 = cA + (size_t)(t + 1) * kstep;
            const char* a2 = last ? nA : cA + (size_t)(t + 2) * kstep; const char* b2 = last ? nB : cB + (size_t)(t + 2) * kstep;
            const char* a3 = a2 + kstep; const char* b3 = b2 + kstep;
            if (last && has_next) S.a_ready(nxt);
            if constexpr (SP2) {
            PG8_LDB(B0, 0, 0); PG8_LDB(B1, 0, 1); PG8_SCHED; PG8_LDA(At, 0, 0); PG8_STAGE(PG8_SA(1, 1), a1 + hstep, voffA);
            PG8_WAIT_V(8); PG8_WAIT_L(0); PG8_BAR; PG8_MMA(0, 0, At, B0); PG8_MMA(0, 1, At, B1); PG8_BAR; PG8_SCHED;
            PG8_LDA(At, 0, 1); PG8_STAGE(PG8_SB(0, 0), b2, voffB); PG8_STAGE(PG8_SB(0, 1), b2 + hstep, voffB); PG8_STAGE(PG8_SA(0, 0), a2, voffA);
            PG8_WAIT_V(8); PG8_WAIT_L(0); PG8_BAR; PG8_MMA(1, 0, At, B0); PG8_MMA(1, 1, At, B1); PG8_BAR; PG8_SCHED;
            PG8_LDB(B0, 1, 0); PG8_LDB(B1, 1, 1); PG8_SCHED; PG8_LDA(At, 1, 0); PG8_STAGE(PG8_SA(0, 1), a2 + hstep, voffA);
            PG8_WAIT_V(8); PG8_WAIT_L(0); PG8_BAR; PG8_MMA(0, 0, At, B0); PG8_MMA(0, 1, At, B1); PG8_BAR; PG8_SCHED;
            PG8_LDA(At, 1, 1); PG8_STAGE(PG8_SB(1, 0), b3, voffB); PG8_STAGE(PG8_SB(1, 1), b3 + hstep, voffB); PG8_STAGE(PG8_SA(1, 0), a3, voffA);
            PG8_WAIT_V(8); PG8_WAIT_L(0); PG8_BAR; PG8_MMA(1, 0, At, B0); PG8_MMA(1, 1, At, B1); PG8_BAR; PG8_SCHED;
            } else {
            PG8_LDB(B0, 0, 0); PG8_SCHED; PG8_LDA(At, 0, 0); PG8_STAGE(PG8_SA(1, 1), a1 + hstep, voffA);
            PG8_WAIT_L(8); PG8_BAR; PG8_WAIT_L(0); PG8_MMA(0, 0, At, B0); PG8_BAR; PG8_SCHED;
            PG8_LDB(B1, 0, 1); PG8_STAGE(PG8_SB(0, 0), b2, voffB);
            PG8_BAR; PG8_WAIT_L(0); PG8_MMA(0, 1, At, B1); PG8_BAR;
            PG8_LDA(At, 0, 1); PG8_STAGE(PG8_SA(0, 0), a2, voffA);
            PG8_BAR; PG8_WAIT_L(0); PG8_MMA(1, 0, At, B0); PG8_BAR; PG8_SCHED;
            PG8_STAGE(PG8_SB(0, 1), b2 + hstep, voffB);
            PG8_WAIT_V(6); PG8_BAR; PG8_MMA(1, 1, At, B1); PG8_BAR;
            PG8_LDB(B0, 1, 0); PG8_SCHED; PG8_LDA(At, 1, 0); PG8_STAGE(PG8_SA(0, 1), a2 + hstep, voffA);
            PG8_WAIT_L(8); PG8_BAR; PG8_WAIT_L(0); PG8_MMA(0, 0, At, B0); PG8_BAR; PG8_SCHED;
            PG8_LDB(B1, 1, 1); PG8_STAGE(PG8_SB(1, 0), b3, voffB);
            PG8_BAR; PG8_WAIT_L(0); PG8_MMA(0, 1, At, B1); PG8_BAR;
            PG8_LDA(At, 1, 1); PG8_STAGE(PG8_SA(1, 0), a3, voffA);
            PG8_BAR; PG8_WAIT_L(0); PG8_MMA(1, 0, At, B0); PG8_BAR; PG8_SCHED;
            PG8_STAGE(PG8_SB(1, 1), b3 + hstep, voffB);
            PG8_WAIT_V(6); PG8_BAR; PG8_MMA(1, 1, At, B1); PG8_BAR;
            }
        }
        if constexpr (ALIGN_EPI) { if (wr == 0) PG8_BAR; }
        if constexpr (!Epi::AFTER_DRAIN) { E(acc, cur, wr, wc, fr, fq); S.done(cur); }
        if (!has_next) break;
#pragma unroll
        for (int a = 0; a < 2; ++a)
#pragma unroll
            for (int b = 0; b < 2; ++b)
#pragma unroll
                for (int m = 0; m < 4; ++m)
#pragma unroll
                    for (int n = 0; n < 2; ++n) acc[a][b][m][n] = (f32x4){0.f, 0.f, 0.f, 0.f};
        cur = nxt; cA = nA; cB = nB; ++ui;
        if constexpr (ALIGN_EPI) { if (wr == 1) PG8_BAR; }
    }
    PG8_WAIT_V(0);
    if constexpr (!ALIGN_EPI) { if (wr == 0) PG8_BAR; }
    PG8_BAR;
    if constexpr (Epi::AFTER_DRAIN) { E.fused(acc, cur, wr, wc, fr, fq, lds, wid, lane); S.done(cur); }
#undef PG8_SA
#undef PG8_SB
#undef PG8_STAGE
#undef PG8_LDA
#undef PG8_LDB
#undef PG8_MMA
#undef PG8_WAIT_V
#undef PG8_WAIT_L
#undef PG8_BAR
#undef PG8_SCHED
}
}
namespace att {
#define LAS3 __attribute__((address_space(3)))
using bf16x8 = __attribute__((ext_vector_type(8))) short;
using s16x4 = __attribute__((ext_vector_type(4))) short;
using f32x16 = __attribute__((ext_vector_type(16))) float;
using f32x4 = __attribute__((ext_vector_type(4))) float;
using u32x4 = __attribute__((ext_vector_type(4))) unsigned;
constexpr int NW = 8, QBLK = 32, QB = 256, KVBLK = 64;
constexpr int LDS_K = 0, LDS_V = 12288, LDS_CUM = 20480, LDS_WS = 28672, LDS_TMP = 30720, LDS_OST = 31744, LDS_BYTES = LDS_OST + NW * 8192;
__device__ __forceinline__ int crow(int r, int hi) { return (r & 3) + 8 * (r >> 2) + 4 * hi; }
typedef float f32x2_t __attribute__((ext_vector_type(2))); typedef __bf16 bf16x2_t __attribute__((ext_vector_type(2)));
__device__ __forceinline__ unsigned cvtpk_s(float lo, float hi) { f32x2_t v = {lo, hi}; bf16x2_t b = __builtin_convertvector(v, bf16x2_t); return __builtin_bit_cast(unsigned, b); }
__device__ __forceinline__ float bf_lo(unsigned u) { return __uint_as_float(u << 16); }
__device__ __forceinline__ float bf_hi(unsigned u) { return __uint_as_float(u & 0xffff0000u); }
#define ATT_SBAR() __builtin_amdgcn_sched_barrier(0)
__device__ __forceinline__ float rowmax(const f32x16& p0, const f32x16& p1) {
    float a = fmaxf(p0[0], p1[0]);
#pragma unroll
    for (int r = 1; r < 16; ++r) a = fmaxf(a, fmaxf(p0[r], p1[r]));
    auto rr = __builtin_amdgcn_permlane32_swap(__float_as_uint(a), __float_as_uint(a), false, false);
    return fmaxf(__uint_as_float(rr[0]), __uint_as_float(rr[1]));
}
__device__ __forceinline__ void pv(f32x16* o, int vb, bf16x8 pa0, bf16x8 pa1, bf16x8 pa2, bf16x8 pa3) {
#pragma unroll
    for (int d0 = 0; d0 < 2; ++d0) { s16x4 lo[4], hi[4];
#pragma unroll
        for (int ks = 0; ks < 4; ++ks) {
            asm volatile("ds_read_b64_tr_b16 %0,%1 offset:%c2" : "=&v"(lo[ks]) : "v"(vb), "i"(d0 * 4096 + ks * 1024) : "memory");
            asm volatile("ds_read_b64_tr_b16 %0,%1 offset:%c2" : "=&v"(hi[ks]) : "v"(vb), "i"(d0 * 4096 + ks * 1024 + 512) : "memory"); }
        asm volatile("s_waitcnt lgkmcnt(0)" ::: "memory"); ATT_SBAR();
#define ATT_PK(k) (bf16x8){lo[k][0], lo[k][1], lo[k][2], lo[k][3], hi[k][0], hi[k][1], hi[k][2], hi[k][3]}
        o[d0] = __builtin_amdgcn_mfma_f32_32x32x16_bf16(pa0, ATT_PK(0), o[d0], 0, 0, 0);
        o[d0] = __builtin_amdgcn_mfma_f32_32x32x16_bf16(pa1, ATT_PK(1), o[d0], 0, 0, 0);
        o[d0] = __builtin_amdgcn_mfma_f32_32x32x16_bf16(pa2, ATT_PK(2), o[d0], 0, 0, 0);
        o[d0] = __builtin_amdgcn_mfma_f32_32x32x16_bf16(pa3, ATT_PK(3), o[d0], 0, 0, 0);
#undef ATT_PK
    }
}
struct Tensors {
    const unsigned short *Q1, *Q2, *K1, *K2, *V, *G; unsigned short* Y;
};
__device__ __forceinline__ void fox_cum(const float* LOGF, int b, int h, LAS3 float* cum, LAS3 float* tmp8, int wid  ) {
    const int lane = pg8::lane_id_asm(), tid = wid * 64 + lane;
    const float* src = LOGF + ((size_t)b * SEQ + 4 * tid) * 8 + h;
    const float v0 = src[0], v1 = src[8], v2 = src[16], v3 = src[24];
    const float p0 = v0, p1 = p0 + v1, p2 = p1 + v2, p3 = p2 + v3;
    float incl = p3;
#pragma unroll
    for (int off = 1; off < 64; off <<= 1) { const float t = __shfl_up(incl, off); if (lane >= off) incl += t; }
    if (lane == 63) tmp8[wid] = incl;
    __syncthreads();
    float base = incl - p3;
    for (int w = 0; w < wid; ++w) base += tmp8[w];
    cum[4 * tid + 0] = (base + p0) * LOG2E; cum[4 * tid + 1] = (base + p1) * LOG2E; cum[4 * tid + 2] = (base + p2) * LOG2E; cum[4 * tid + 3] = (base + p3) * LOG2E;
    __syncthreads();
}
template <int MODE> __device__ __forceinline__ void attn_unit(int b, int h, int qb, const Tensors& T, LAS3 unsigned char* lds, int wid  ) {
    constexpr int NQ = MODE ? 6 : 4;
    const int lane = pg8::lane_id_asm(), r32 = lane & 31, hi = lane >> 5;
    const size_t rowbase = (size_t)b * SEQ; const int q0 = qb * QB, NT = (q0 + QB) / KVBLK;
    const int qpos = q0 + wid * QBLK + r32;
    LAS3 float* wsf = (LAS3 float*)(lds + LDS_WS) + wid * 64;
    LAS3 const float* cum = (LAS3 const float*)(lds + LDS_CUM);
    bf16x8 qr[NQ];
#pragma unroll
    for (int d0 = 0; d0 < 4; ++d0) qr[d0] = *(const bf16x8*)(T.Q1 + (rowbase + qpos) * 512 + h * 64 + d0 * 16 + hi * 8);
    if (MODE) {
#pragma unroll
        for (int d0 = 0; d0 < 2; ++d0) qr[4 + d0] = *(const bf16x8*)(T.Q2 + (rowbase + qpos) * 256 + h * 32 + d0 * 16 + hi * 8); }
    float m_run = -INFINITY, l_run = 0.f; f32x16 o[2]; o[0] = f32x16{}; o[1] = f32x16{};
    const float cq = MODE ? 0.f : cum[qpos];
    const int vb0 = (int)(unsigned)(uintptr_t)(lds + LDS_V) + ((lane >> 4) & 1) * 32 + (lane & 3) * 8 + (4 * hi + ((lane & 15) >> 2)) * 64;
    for (int t = 0; t < NT; ++t) {
        __syncthreads();
        { const size_t krow = rowbase + (size_t)t * KVBLK;
          const u32x4 kv = *(const u32x4*)(T.K1 + (krow + lane) * 512 + h * 64 + wid * 8);
          const u32x4 vv = *(const u32x4*)(T.V + (krow + 16 * (wid & 3) + (lane >> 2)) * 512 + h * 64 + (wid >> 2) * 32 + (lane & 3) * 8);
          *(LAS3 u32x4*)(lds + LDS_K + wid * 1024 + lane * 16) = kv;
          *(LAS3 u32x4*)(lds + LDS_V + wid * 1024 + lane * 16) = vv;
          if (MODE && wid < 4) { const u32x4 k2 = *(const u32x4*)(T.K2 + (krow + lane) * 32 + wid * 8); *(LAS3 u32x4*)(lds + LDS_K + (8 + wid) * 1024 + lane * 16) = k2; } }
        __syncthreads();
        f32x16 p0 = f32x16{}, p1 = f32x16{};
#pragma unroll
        for (int d0 = 0; d0 < NQ; ++d0) {
            const bf16x8 b0 = *(LAS3 const bf16x8*)(lds + LDS_K + (2 * d0 + hi) * 1024 + r32 * 16);
            const bf16x8 b1 = *(LAS3 const bf16x8*)(lds + LDS_K + (2 * d0 + hi) * 1024 + 512 + r32 * 16);
            p0 = __builtin_amdgcn_mfma_f32_32x32x16_bf16(b0, qr[d0], p0, 0, 0, 0); p1 = __builtin_amdgcn_mfma_f32_32x32x16_bf16(b1, qr[d0], p1, 0, 0, 0); }
        if (MODE == 0) {
            const int kb = t * KVBLK + 4 * hi;
#pragma unroll
            for (int g = 0; g < 4; ++g) { const f32x4 c0 = *(LAS3 const f32x4*)(cum + kb + 8 * g), c1 = *(LAS3 const f32x4*)(cum + kb + 32 + 8 * g);
#pragma unroll
                for (int e = 0; e < 4; ++e) { const int kv = kb + 8 * g + e;
                    p0[4 * g + e] = (kv > qpos) ? -INFINITY : p0[4 * g + e] + (cq - c0[e]);
                    p1[4 * g + e] = (kv + 32 > qpos) ? -INFINITY : p1[4 * g + e] + (cq - c1[e]); } }
        } else {
            if (t > (qpos >> 6)) {
#pragma unroll
                for (int r = 0; r < 16; ++r) { p0[r] = -INFINITY; p1[r] = -INFINITY; } }
        }
        const float rm = rowmax(p0, p1), m_new = fmaxf(m_run, rm), alpha = __builtin_amdgcn_exp2f(m_run - m_new);
        float sum = 0.f;
#pragma unroll
        for (int r = 0; r < 16; ++r) { p0[r] = __builtin_amdgcn_exp2f(p0[r] - m_new); p1[r] = __builtin_amdgcn_exp2f(p1[r] - m_new); sum += p0[r] + p1[r]; }
        l_run = l_run * alpha + sum; m_run = m_new;
        if (hi == 0) wsf[r32] = alpha;
        asm volatile("s_waitcnt lgkmcnt(0)" ::: "memory");
#pragma unroll
        for (int d = 0; d < 2; ++d)
#pragma unroll
            for (int r = 0; r < 16; ++r) o[d][r] *= wsf[crow(r, hi)];
        asm volatile("s_waitcnt lgkmcnt(0)" ::: "memory");
        u32x4 pw0, pw1, pw2, pw3;
        pw0 = (u32x4){cvtpk_s(p0[0], p0[1]), cvtpk_s(p0[2], p0[3]), cvtpk_s(p0[4], p0[5]), cvtpk_s(p0[6], p0[7])};
        pw1 = (u32x4){cvtpk_s(p0[8], p0[9]), cvtpk_s(p0[10], p0[11]), cvtpk_s(p0[12], p0[13]), cvtpk_s(p0[14], p0[15])};
        pw2 = (u32x4){cvtpk_s(p1[0], p1[1]), cvtpk_s(p1[2], p1[3]), cvtpk_s(p1[4], p1[5]), cvtpk_s(p1[6], p1[7])};
        pw3 = (u32x4){cvtpk_s(p1[8], p1[9]), cvtpk_s(p1[10], p1[11]), cvtpk_s(p1[12], p1[13]), cvtpk_s(p1[14], p1[15])};
        ATT_SBAR();
        pv(o, vb0, __builtin_bit_cast(bf16x8, pw0), __builtin_bit_cast(bf16x8, pw1), __builtin_bit_cast(bf16x8, pw2), __builtin_bit_cast(bf16x8, pw3));
    }
    { auto rr = __builtin_amdgcn_permlane32_swap(__float_as_uint(l_run), __float_as_uint(l_run), false, false); l_run = __uint_as_float(rr[0]) + __uint_as_float(rr[1]); }
    if (hi == 0) wsf[32 + r32] = l_run;
    asm volatile("s_waitcnt lgkmcnt(0)" ::: "memory");
    LAS3 float* stg = (LAS3 float*)(lds + LDS_OST + wid * 8192);
#pragma unroll
    for (int r = 0; r < 16; ++r) { const int orow = crow(r, hi); const float rl = __builtin_amdgcn_rcpf(wsf[32 + orow]);
#pragma unroll
        for (int d0 = 0; d0 < 2; ++d0) stg[orow * 64 + d0 * 32 + r32] = o[d0][r] * rl; }
    asm volatile("s_waitcnt lgkmcnt(0)" ::: "memory");
#pragma unroll
    for (int i = 0; i < 4; ++i) { const int row = i * 8 + (lane >> 3), ch = lane & 7;
        const f32x4 a0 = *(LAS3 const f32x4*)(stg + row * 64 + ch * 8), a1 = *(LAS3 const f32x4*)(stg + row * 64 + ch * 8 + 4);
        const size_t gi = (rowbase + q0 + wid * QBLK + row) * 512 + h * 64 + ch * 8;
        const u32x4 g = *(const u32x4*)(T.G + gi);
        u32x4 w; w.x = cvtpk_s(a0[0] * bf_lo(g.x), a0[1] * bf_hi(g.x)); w.y = cvtpk_s(a0[2] * bf_lo(g.y), a0[3] * bf_hi(g.y));
        w.z = cvtpk_s(a1[0] * bf_lo(g.z), a1[1] * bf_hi(g.z)); w.w = cvtpk_s(a1[2] * bf_lo(g.w), a1[3] * bf_hi(g.w));
        *(u32x4*)(T.Y + gi) = w; }
    asm volatile("s_waitcnt lgkmcnt(0)" ::: "memory");
}
#undef ATT_SBAR
}

constexpr int NWAVES = 8;
#ifndef MK_N_LAUNCHES
#define MK_N_LAUNCHES 7
#endif
constexpr int N_PHASES = 7;
constexpr int N_LAUNCHES = MK_N_LAUNCHES;
static_assert(N_LAUNCHES == 1 || N_LAUNCHES == N_PHASES, "MK_N_LAUNCHES is 1 or 7");

constexpr int CW_BAR = 4096;

constexpr int RING_OFF = 0, RING_BYTES = 131072;
constexpr int LDSCTL_OFF = RING_BYTES, MISC_OFF = LDSCTL_OFF + 320;
constexpr int LDS_BYTES = 147456;
static_assert(att::LDS_BYTES <= RING_BYTES, "attention scratch fits the ring region");

#define GAS __attribute__((address_space(1)))
#define LAS __attribute__((address_space(3)))
typedef unsigned short bf16;
typedef unsigned v4u __attribute__((ext_vector_type(4)));
typedef float f32x4 __attribute__((ext_vector_type(4)));
typedef short bf16x8 __attribute__((ext_vector_type(8)));
typedef GAS unsigned gu32;
typedef GAS unsigned long long gu64;
#define RLX_AGENT __ATOMIC_RELAXED, __HIP_MEMORY_SCOPE_AGENT
#define LDS_WAIT() asm volatile("s_waitcnt lgkmcnt(0)" ::: "memory")
#define VM_WAIT() asm volatile("s_waitcnt vmcnt(0)" ::: "memory")
__device__ __forceinline__ unsigned long long rt() { return __builtin_amdgcn_s_memrealtime(); }
__device__ __forceinline__ unsigned f2bf(float f) { unsigned u = __builtin_bit_cast(unsigned, f); return (u + 0x7fffu + ((u >> 16) & 1u)) >> 16; }
__device__ __forceinline__ unsigned pk2(float lo, float hi) { return f2bf(lo) | (f2bf(hi) << 16); }

#define XB_TMO      128
#define XB_XCNT(j)  (256  + 64 * (j))
#define XB_XSUB(j)  (1280 + 64 * (j))
#define XB_XGEN(j)  (2304 + 64 * (j))
#define XB_TOP      3328
#define XB_TOPGEN   3392
#define XCD_BAR_WORDS 3456
#define XB_SPIN_CAP (1u << 18)

__device__ __forceinline__ unsigned xb_ld(unsigned* p)              { return __hip_atomic_load(p, __ATOMIC_RELAXED, __HIP_MEMORY_SCOPE_AGENT); }
__device__ __forceinline__ unsigned xb_add(unsigned* p, unsigned v) { return __hip_atomic_fetch_add(p, v, __ATOMIC_RELAXED, __HIP_MEMORY_SCOPE_AGENT); }
__device__ __forceinline__ unsigned xb_xcc_id() { return (unsigned)__builtin_amdgcn_s_getreg((3 << 11) | 20) & 0xFu; }
#define XB_SPIN(cond, bar) do { unsigned _sp = 0; while (cond) { __builtin_amdgcn_s_sleep(1); \
    if ((++_sp & 255u) == 0u) { if (xb_ld(&(bar)[XB_TMO])) break; if (_sp > XB_SPIN_CAP) { atomicAdd(&(bar)[XB_TMO], 1u); break; } } } } while (0)

struct XcdBarrier {
    unsigned* bar; unsigned x;
    volatile LAS unsigned* st;
};

__device__ __forceinline__ XcdBarrier xcd_barrier_post(unsigned* bar, volatile LAS unsigned* st) {
    XcdBarrier b; b.bar = bar; b.x = xb_xcc_id(); b.st = st;
    if (threadIdx.x == 0) (void)xb_add(&bar[XB_XCNT(b.x)], 1u);
    return b;
}
__device__ __forceinline__ void xcd_barrier_complete(unsigned* bar, unsigned x, unsigned& nloc, unsigned& nx) {
    const unsigned G = gridDim.x * gridDim.y * gridDim.z;
    unsigned sum, cnt, mine, sp = 0u;
    for (;;) {
        sum = 0u; cnt = 0u; mine = 0u;
#pragma unroll
        for (unsigned j = 0; j < 16; ++j) { const unsigned c = xb_ld(&bar[XB_XCNT(j)]); sum += c; cnt += (c > 0u) ? 1u : 0u; mine = (j == x) ? c : mine; }
        if (sum == G) break;
        __builtin_amdgcn_s_sleep(1);
        if ((++sp & 255u) == 0u) { if (xb_ld(&bar[XB_TMO])) break; if (sp > XB_SPIN_CAP) { atomicAdd(&bar[XB_TMO], 1u); break; } }
    }
    nloc = mine > 0u ? mine : 1u; nx = cnt > 0u ? cnt : 1u;
}

__device__ __forceinline__ void xcd_barrier(const XcdBarrier& b) {
    asm volatile("s_waitcnt vmcnt(0)" ::: "memory");
    __syncthreads();
    if (threadIdx.x == 0) {
        unsigned* bar = b.bar;
        __builtin_amdgcn_s_waitcnt(0);
        unsigned nloc = b.st[0], nx = b.st[1];
        if (nloc == 0u) { xcd_barrier_complete(bar, b.x, nloc, nx); b.st[0] = nloc; b.st[1] = nx; }
        const unsigned old = xb_add(&bar[XB_XSUB(b.x)], 1u);
        const unsigned gen = old / nloc;
        if (old + 1u == (gen + 1u) * nloc) {
            __builtin_amdgcn_fence(__ATOMIC_RELEASE, "agent");
            asm volatile("s_waitcnt vmcnt(0)" ::: "memory");
            const unsigned og = xb_add(&bar[XB_TOP], 1u);
            const unsigned tg = og / nx;
            if (og + 1u == (tg + 1u) * nx) xb_add(&bar[XB_TOPGEN], 1u);
            else XB_SPIN(xb_ld(&bar[XB_TOPGEN]) == tg, bar);
            __builtin_amdgcn_fence(__ATOMIC_ACQUIRE, "agent");
            xb_add(&bar[XB_XGEN(b.x)], 1u);
            asm volatile("s_waitcnt vmcnt(0)" ::: "memory");
        } else {
            XB_SPIN(xb_ld(&bar[XB_XGEN(b.x)]) == gen, bar);
            __builtin_amdgcn_fence(__ATOMIC_ACQUIRE, "agent");
            asm volatile("s_waitcnt vmcnt(0)" ::: "memory");
        }
    }
    __syncthreads();
}

struct Frame {
    LAS unsigned char* lds;
    volatile LAS unsigned* MISC;
    gu32* ctl;
    int wave;
    int vcu, G;
};
__device__ const float INVF[16] = {1.000000000e+00f, 5.623413324e-01f, 3.162277639e-01f, 1.778279394e-01f, 1.000000015e-01f, 5.623413250e-02f, 3.162277490e-02f, 1.778279431e-02f,
                                   9.999999776e-03f, 5.623413250e-03f, 3.162277630e-03f, 1.778279431e-03f, 1.000000047e-03f, 5.623413017e-04f, 3.162277571e-04f, 1.778279402e-04f};

__device__ __forceinline__ void p0_transpose_item(const float* W, int K, int Nsrc, int src_col0, int nvalid, const float* kscale, bf16* WT, int dst_row0, LAS float* scr, int kb, int lane) {
    const int k0 = 64 * kb, c = lane & 31;
#pragma unroll 8
    for (int i = 0; i < 32; ++i) { const int kk = 2 * i + (lane >> 5); float v = 0.f; if (c < nvalid) v = W[(size_t)(k0 + kk) * Nsrc + src_col0 + c]; if (kscale) v *= kscale[k0 + kk]; scr[kk * 33 + c] = v; }
    LDS_WAIT(); asm volatile("" ::: "memory");
    const int ch = lane & 7;
#pragma unroll
    for (int j = 0; j < 4; ++j) { const int n = (lane >> 3) + 8 * j; const LAS float* s = scr + (8 * ch) * 33 + n;
        v4u o; o.x = pk2(s[0 * 33], s[1 * 33]); o.y = pk2(s[2 * 33], s[3 * 33]); o.z = pk2(s[4 * 33], s[5 * 33]); o.w = pk2(s[6 * 33], s[7 * 33]);
        *(GAS v4u*)(WT + (size_t)(dst_row0 + n) * K + k0 + 8 * ch) = o; }
    LDS_WAIT(); asm volatile("" ::: "memory");
}
__device__ __forceinline__ void win_block_src(int nb, int& src, int& nvalid) {
    const int tile = nb >> 3, blk = nb & 7, bj = blk >> 2, wc = blk & 3; nvalid = 32;
    if (tile < 2) src = OC_QB + tile * 256 + 64 * wc + 32 * bj;
    else if (tile < 4) src = OC_KB + (tile - 2) * 256 + 64 * wc + 32 * bj;
    else if (tile < 6) src = OC_VB + (tile - 4) * 256 + 32 * blk;
    else if (tile < 8) src = OC_GA + (tile - 6) * 256 + 32 * blk;
    else if (tile < 10) src = OC_GB + (tile - 8) * 256 + 32 * blk;
    else if (tile < 14) src = OC_MA + (tile - 10) * 256 + 32 * blk;
    else if (tile < 18) src = OC_MB + (tile - 14) * 256 + 32 * blk;
    else if (tile == 18) src = OC_CKV + 32 * blk;
    else if (tile == 19) src = OC_CQ + 32 * blk;
    else { if (blk < 4) src = OC_CQ + 256 + 32 * blk; else if (blk == 4) src = OC_KR; else if (blk == 5) { src = OC_FB; nvalid = 8; } else { src = 0; nvalid = 0; } }
}
struct Args { const float* in[21]; float* out; unsigned char* ws; int ph_lo, ph_hi, li, pad; };

__device__ __forceinline__ float wave_sum(float v) {
#pragma unroll
    for (int o = 1; o < 64; o <<= 1) v += __shfl_xor(v, o);
    return v;
}

__device__ __forceinline__ void p0_prologue(Frame& F, const Args& a) {
    unsigned char* ws = a.ws; const int lane = pg8::lane_id_asm(), tid = F.wave * 64 + lane;
    LAS float* scr = (LAS float*)(F.lds + RING_OFF + F.wave * 16384);
    const int gw = F.vcu * NWAVES + F.wave, NGW = F.G * NWAVES;
    const float *w_in = a.in[6], *w_uq = a.in[10], *w_ukv = a.in[11], *w_a = a.in[18], *w_b = a.in[19], *w_out = a.in[20];
    bf16 *Win_t = (bf16*)(ws + WSO_WIN), *Wuq_t = (bf16*)(ws + WSO_WUQ), *Wukv_t = (bf16*)(ws + WSO_WUKV), *Wa_t = (bf16*)(ws + WSO_WA), *Wb_t = (bf16*)(ws + WSO_WB), *Wout_t = (bf16*)(ws + WSO_WOUT);
    constexpr int I_IN = 16 * 168, I_UQ = 6 * 24, I_UKV = 4 * 32, I_A = 8 * 32, I_B = 8 * 32, I_OUT = 16 * 32;
    constexpr int NITEMS = I_IN + I_UQ + I_UKV + I_A + I_B + I_OUT;
    for (int it = gw; it < NITEMS; it += NGW) {
        int r = it;
        if (r < I_IN) { const int kb = r / 168, nb = r % 168; int src, nv; win_block_src(nb, src, nv); p0_transpose_item(w_in, 1024, DIN, src, nv, nullptr, Win_t, nb * 32, scr, kb, lane); continue; } r -= I_IN;
        if (r < I_UQ) { const int kb = r / 24, nb = r % 24, tile = nb >> 3, blk = nb & 7, bj = blk >> 2, wc = blk & 3;
            const int src = (tile < 2) ? (4 * tile + wc) * 96 + 32 * bj : (4 * bj + wc) * 96 + 64;
            p0_transpose_item(w_uq, 384, 768, src, 32, a.in[8], Wuq_t, nb * 32, scr, kb, lane); continue; } r -= I_UQ;
        if (r < I_UKV) { const int kb = r / 32, nb = r % 32, tile = nb >> 3, blk = nb & 7, bj = blk >> 2, wc = blk & 3;
            const int src = (tile < 2) ? (4 * tile + wc) * 128 + 32 * bj : (4 * (tile - 2) + (blk >> 1)) * 128 + 64 + 32 * (blk & 1);
            p0_transpose_item(w_ukv, 256, 1024, src, 32, a.in[9], Wukv_t, nb * 32, scr, kb, lane); continue; } r -= I_UKV;
        if (r < I_A) { p0_transpose_item(w_a, 512, 1024, (r % 32) * 32, 32, nullptr, Wa_t, (r % 32) * 32, scr, r / 32, lane); continue; } r -= I_A;
        if (r < I_B) { p0_transpose_item(w_b, 512, 1024, (r % 32) * 32, 32, nullptr, Wb_t, (r % 32) * 32, scr, r / 32, lane); continue; } r -= I_B;
        p0_transpose_item(w_out, 1024, 1024, (r % 32) * 32, 32, nullptr, Wout_t, (r % 32) * 32, scr, r / 32, lane);
    }
    if (gw == 0) { float* PAR = (float*)(ws + WSO_PAR); const int l = lane;
        PAR[PAR_QNB + l] = a.in[16][l]; PAR[PAR_KNB + l] = a.in[17][l]; PAR[PAR_QNNOPE + l] = a.in[12][l]; PAR[PAR_KNNOPE + l] = a.in[14][l];
        if (l < 32) { PAR[PAR_KNROPE + l] = a.in[15][l]; PAR[PAR_QNROPE + l] = a.in[13][l]; }
        if (l < 8) PAR[PAR_BF + l] = a.in[7][l]; }
    { const float *c = a.in[1], *w_ada = a.in[3], *b_ada = a.in[4]; float* ADA = (float*)(ws + WSO_ADA);
      for (int it = gw; it < 48 * BATCH; it += NGW) { const int cb = it % 48, b = it / 48, col = 64 * cb + lane; const float* cr = c + (size_t)b * 1024; const float* wp = w_ada + col;
          float acc0 = 0.f, acc1 = 0.f, acc2 = 0.f, acc3 = 0.f;
#pragma unroll 4
          for (int k = 0; k < 1024; k += 4) { acc0 = fmaf(cr[k], wp[(size_t)k * 3072], acc0); acc1 = fmaf(cr[k + 1], wp[(size_t)(k + 1) * 3072], acc1);
              acc2 = fmaf(cr[k + 2], wp[(size_t)(k + 2) * 3072], acc2); acc3 = fmaf(cr[k + 3], wp[(size_t)(k + 3) * 3072], acc3); }
          ADA[(size_t)b * 3072 + col] = ((acc0 + acc1) + (acc2 + acc3)) + b_ada[col]; } }
    { const int* pos = (const int*)a.in[2]; float* COS = (float*)(ws + WSO_COS); float* SIN = (float*)(ws + WSO_SIN);
      const int gt = F.vcu * (NWAVES * 64) + tid, NGT = F.G * NWAVES * 64;
      for (int e = gt; e < MTOK * 16; e += NGT) { const float ang = (float)pos[e >> 4] * INVF[e & 15]; COS[e] = cosf(ang); SIN[e] = sinf(ang); } }
}
__device__ __forceinline__ void p1_xn(Frame& F, const Args& a) {
    const int lane = pg8::lane_id_asm();
    const float *x = a.in[0], *nw = a.in[5]; const float* ADA = (const float*)(a.ws + WSO_ADA); bf16* XN = (bf16*)(a.ws + WSO_XN);
    const int gw = F.vcu * NWAVES + F.wave, NGW = F.G * NWAVES;
    for (int m = gw; m < MTOK; m += NGW) {
        const GAS f32x4* xr = (const GAS f32x4*)(x + (size_t)m * DMODEL) + lane;
        const float* ad = ADA + (size_t)(m >> 11) * 3072;
        f32x4 v[4]; float s = 0.f;
#pragma unroll
        for (int j = 0; j < 4; ++j) { v[j] = xr[64 * j]; s += (v[j].x * v[j].x + v[j].y * v[j].y) + (v[j].z * v[j].z + v[j].w * v[j].w); }
        const float rstd = rsqrtf(wave_sum(s) * (1.f / DMODEL) + EPS);
        GAS unsigned long long* o8 = (GAS unsigned long long*)(XN + (size_t)m * DMODEL) + lane;
#pragma unroll
        for (int j = 0; j < 4; ++j) { const int col = 4 * lane + 256 * j;
            const f32x4 w = *(const f32x4*)(nw + col), sh = *(const f32x4*)(ad + col), sc = *(const f32x4*)(ad + 1024 + col);
            const f32x4 h = v[j] * rstd * w * (sc + 1.0f) + sh;
            o8[64 * j] = (unsigned long long)pk2(h.x, h.y) | ((unsigned long long)pk2(h.z, h.w) << 32); }
    }
}

__global__ void __launch_bounds__(NWAVES * 64, 2) mk_fwd(Args args) {
    extern __shared__ __attribute__((aligned(16))) unsigned char lds[];
    Frame F;
    F.lds = (LAS unsigned char*)lds;
    F.MISC = (volatile LAS unsigned*)(F.lds + MISC_OFF);
    F.wave = __builtin_amdgcn_readfirstlane(threadIdx.x >> 6);
    F.G = gridDim.x; { const int bx = blockIdx.x; F.vcu = (F.G % 8 == 0) ? (bx % 8) * (F.G / 8) + bx / 8 : bx; }
    F.ctl = (gu32*)(args.ws + WSO_CTL);
    for (int u = threadIdx.x; u < (LDS_BYTES - LDSCTL_OFF) / 4; u += NWAVES * 64) ((LAS unsigned*)(F.lds + LDSCTL_OFF))[u] = 0u;
    __syncthreads();
    XcdBarrier bar; bar.bar = (unsigned*)(F.ctl + CW_BAR); bar.x = 0; bar.st = nullptr;
    if (N_LAUNCHES == 1) bar = xcd_barrier_post((unsigned*)(F.ctl + CW_BAR), F.MISC + 8);
#define GRID_BAR() do { if (N_LAUNCHES == 1) xcd_barrier(bar); } while (0)
    const int lo = args.ph_lo, hi = args.ph_hi;
#ifndef PHASE_MASK
#define PHASE_MASK 0x7f
#endif
#define IN(k) (((PHASE_MASK >> (k)) & 1) && lo <= (k) && (k) < hi)
#define BOTH(k) (IN(k) && IN((k) + 1))
    typedef pg8::bf16_t hb;
#define WSP(off) (wsp + (off))
#define PHASE_WS() unsigned char* wsp = args.ws; asm volatile("" : "+s"(wsp))
    if (IN(0)) { p0_prologue(F, args); if (BOTH(0)) GRID_BAR(); }
    if (IN(1)) { p1_xn(F, args); if (BOTH(1)) GRID_BAR(); }
    if (IN(2)) { PHASE_WS();
        pg8::Gemm g{(hb*)WSP(WSO_XN), (hb*)WSP(WSO_WIN), MTOK, NIN, 1024}; pg8::StaticOrder S; S.init(MTOK, NIN, F.G, (int)blockIdx.x);
        pg8::EpiIn E{wsp};
        pg8::gemm_phase<pg8::EpiIn, pg8::StaticOrder, true, true>(F.lds + RING_OFF, g, S, E, F.wave);
        if (BOTH(2)) GRID_BAR();
    }
    if (IN(3)) { PHASE_WS();
        { pg8::Gemm g{(hb*)WSP(WSO_CQ), (hb*)WSP(WSO_WUQ), MTOK, 768, 384}; pg8::StaticOrder S; S.init(MTOK, 768, F.G, (int)blockIdx.x);
          pg8::EpiQup E{wsp};
          pg8::gemm_phase<pg8::EpiQup, pg8::StaticOrder, true, true>(F.lds + RING_OFF, g, S, E, F.wave); }
        { pg8::Gemm g{(hb*)WSP(WSO_CKV), (hb*)WSP(WSO_WUKV), MTOK, 1024, 256}; pg8::StaticOrder S; S.init(MTOK, 1024, F.G, (int)blockIdx.x);
          pg8::EpiKVup E{wsp};
          pg8::gemm_phase<pg8::EpiKVup, pg8::StaticOrder, true, true>(F.lds + RING_OFF, g, S, E, F.wave); }
        if (BOTH(3)) GRID_BAR();
    }
    if (IN(4)) { PHASE_WS();
        LAS unsigned char* al = F.lds + RING_OFF; const float* LOGF = (const float*)WSP(WSO_LOGF);
        hb *QB = (hb*)WSP(WSO_QB), *KB = (hb*)WSP(WSO_KB), *VB = (hb*)WSP(WSO_VB), *GB = (hb*)WSP(WSO_GB), *GA = (hb*)WSP(WSO_GA), *QAN = (hb*)WSP(WSO_QAN), *QAR = (hb*)WSP(WSO_QAR), *KAN = (hb*)WSP(WSO_KAN), *KROPE = (hb*)WSP(WSO_KROPE), *VA = (hb*)WSP(WSO_VA);
        for (int bh = (int)blockIdx.x; bh < BATCH * NH; bh += F.G) { const int b = bh >> 3, h = bh & 7;
            __syncthreads();
            att::fox_cum(LOGF, b, h, (LAS float*)(al + att::LDS_CUM), (LAS float*)(al + att::LDS_TMP), F.wave);
            { const att::Tensors T{QB, nullptr, KB, nullptr, VB, GB, QB};
              for (int qb = 0; qb < SEQ / att::QB; ++qb) att::attn_unit<0>(b, h, qb, T, al, F.wave); }
            { const att::Tensors T{QAN, QAR, KAN, KROPE, VA, GA, QAN};
              for (int qb = 0; qb < SEQ / att::QB; ++qb) att::attn_unit<1>(b, h, qb, T, al, F.wave); }
        }
        if (BOTH(4)) GRID_BAR();
    }
    if (IN(5)) { PHASE_WS(); hb* MERGED = (hb*)WSP(WSO_MERGED);
        { pg8::Gemm g{(hb*)WSP(WSO_QAN)  , (hb*)WSP(WSO_WA), MTOK, 1024, 512}; pg8::StaticOrder S; S.init(MTOK, 1024, F.G, (int)blockIdx.x);
          pg8::EpiBranch<false> E{(hb*)WSP(WSO_SA), MERGED};
          pg8::gemm_phase<pg8::EpiBranch<false>, pg8::StaticOrder, true, true>(F.lds + RING_OFF, g, S, E, F.wave); }
        { pg8::Gemm g{(hb*)WSP(WSO_QB)  , (hb*)WSP(WSO_WB), MTOK, 1024, 512}; pg8::StaticOrder S; S.init(MTOK, 1024, F.G, (int)blockIdx.x);
          pg8::EpiBranch<true> E{(hb*)WSP(WSO_SB), MERGED};
          pg8::gemm_phase<pg8::EpiBranch<true>, pg8::StaticOrder, true, true>(F.lds + RING_OFF, g, S, E, F.wave); }
        if (BOTH(5)) GRID_BAR();
    }
    if (IN(6)) { PHASE_WS();
        pg8::Gemm g{(hb*)WSP(WSO_MERGED), (hb*)WSP(WSO_WOUT), MTOK, 1024, 1024}; pg8::StaticOrder S; S.init(MTOK, 1024, F.G, (int)blockIdx.x);
        pg8::EpiOut E{args.in[0], args.out, (const float*)WSP(WSO_ADA) + 2048};
        pg8::gemm_phase<pg8::EpiOut, pg8::StaticOrder, true, true>(F.lds + RING_OFF, g, S, E, F.wave);
    }
#undef IN
#undef BOTH
}

extern "C" void kernel_launch(void* const* d_in, const int* in_sizes, int n_in, void* d_out, int out_size, void* d_ws, size_t ws_size, hipStream_t stream) {
    static int grid = 0;
    if (grid == 0) {
        if (n_in != 21 || in_sizes[0] != MTOK * DMODEL || out_size != MTOK * DMODEL || ws_size < WSO_END) { fprintf(stderr, "kernel_launch: unexpected shapes: n_in %d in0 %d out %d ws %zu (need %zu)\n", n_in, n_in > 0 ? in_sizes[0] : -1, out_size, ws_size, (size_t)WSO_END); grid = -1; return; }
        int dev = 0, cus = 0, per_cu = 0;
        if (hipGetDevice(&dev) != hipSuccess || hipDeviceGetAttribute(&cus, hipDeviceAttributeMultiprocessorCount, dev) != hipSuccess) { fprintf(stderr, "kernel_launch: device query failed\n"); grid = -1; return; }
        if (hipFuncSetAttribute((const void*)mk_fwd, hipFuncAttributeMaxDynamicSharedMemorySize, LDS_BYTES) != hipSuccess) { fprintf(stderr, "kernel_launch: hipFuncSetAttribute failed\n"); grid = -1; return; }
        if (hipOccupancyMaxActiveBlocksPerMultiprocessor(&per_cu, (const void*)mk_fwd, NWAVES * 64, LDS_BYTES) != hipSuccess || per_cu < 1) fprintf(stderr, "kernel_launch: note: occupancy query reports %d workgroups per CU\n", per_cu);
        (void)hipGetLastError();
        grid = cus;
    }
    if (grid < 0) return;
    if (hipMemsetAsync((char*)d_ws + WSO_CTL, 0, CTL_ZERO_BYTES, stream) != hipSuccess) { fprintf(stderr, "kernel_launch: memset failed\n"); return; }
    Args a{};
    for (int i = 0; i < 21; ++i) a.in[i] = (const float*)d_in[i];
    a.out = (float*)d_out; a.ws = (unsigned char*)d_ws;
    for (int li = 0; li < N_LAUNCHES; ++li) {
        a.ph_lo = (N_LAUNCHES == 1) ? 0 : li; a.ph_hi = (N_LAUNCHES == 1) ? N_PHASES : li + 1; a.li = li;
        hipLaunchKernelGGL(mk_fwd, dim3(grid), dim3(NWAVES * 64), LDS_BYTES, stream, a);
        const hipError_t le = hipPeekAtLastError();
        if (le != hipSuccess) { fprintf(stderr, "kernel_launch: launch %d failed: %s\n", li, hipGetErrorName(le)); break; }
    }
}
```

```cpp
#include <hip/hip_runtime.h>
#include <hip/hip_bf16.h>
#include <cstdio>
#include <cstdint>
#include <cmath>

constexpr int BATCH = 32, SEQ = 2048, DMODEL = 1024, MTOK = BATCH * SEQ;
constexpr int QLORA = 384, KVLORA = 256, ROPE = 32, NH = 8, HD = 64;
constexpr int DIN = 5288, NIN = 5376;
constexpr float EPS = 1e-6f;
constexpr float LOG2E = 1.4426950408889634f;
constexpr float C2B = 0.125f * LOG2E;
constexpr float C2A = 0.10206207261596575f * LOG2E;
constexpr int OC_CQ = 0, OC_CKV = 384, OC_KR = 640, OC_GA = 672, OC_QB = 1184, OC_KB = 1696, OC_VB = 2208, OC_FB = 2720, OC_GB = 2728, OC_MA = 3240, OC_MB = 4264;

constexpr size_t MiB = 1u << 20;
constexpr size_t WSO_CTL = 0, CTL_ZERO_BYTES = 32 * 1024;
constexpr size_t WSO_WIN = 2 * MiB, WSO_WUQ = 13 * MiB, WSO_WUKV = 14 * MiB, WSO_WCAT = 15 * MiB, WSO_WOUT = 17 * MiB;
constexpr size_t WSO_ADA = 19 * MiB, WSO_COS = 20 * MiB, WSO_SIN = 24 * MiB, WSO_LOGF = 28 * MiB, WSO_SSQQ = 30 * MiB, WSO_SSQKV = 32 * MiB, WSO_KROPE = 34 * MiB, WSO_PAR = 38 * MiB;
constexpr size_t WSO_XN = 40 * MiB;
constexpr size_t WSO_QAN = WSO_XN, WSO_KAN = WSO_XN + 64 * MiB;
constexpr size_t WSO_CQ = 168 * MiB, WSO_CKV = 216 * MiB;
constexpr size_t WSO_YCAT = 168 * MiB;
constexpr size_t WSO_GA = 296 * MiB, WSO_QB = 360 * MiB, WSO_KB = 424 * MiB, WSO_VB = 488 * MiB, WSO_GB = 552 * MiB;
constexpr size_t WSO_MERGED = WSO_KB;
constexpr size_t WSO_RA = 616 * MiB, WSO_SB = 744 * MiB, WSO_QAR = 872 * MiB, WSO_VA = 904 * MiB, WSO_END = 968 * MiB;
static_assert(WSO_WIN + (size_t)NIN * 1024 * 2 <= WSO_WUQ && WSO_SSQKV + (size_t)MTOK * 16 <= WSO_KROPE && WSO_KROPE + (size_t)MTOK * 64 <= WSO_PAR, "d_ws map");
constexpr int PAR_QNB = 0, PAR_KNB = 64, PAR_KNROPE = 128, PAR_BF = 160, PAR_QNNOPE = 192, PAR_QNROPE = 256, PAR_KNNOPE = 320, PAR_BNDB = 384, PAR_BNDA = 385, PAR_N = 448;

namespace pg8 {
#define PG8_LAS __attribute__((address_space(3)))
typedef unsigned short bf16_t;
typedef short bf16x8 __attribute__((ext_vector_type(8)));
typedef float f32x4 __attribute__((ext_vector_type(4)));
typedef unsigned u32x4 __attribute__((ext_vector_type(4)));
constexpr int BM = 256, BK = 64, HALF = 128, HTB = HALF * BK * 2  , STAGE_BYTES = 8 * HTB, NXCD = 8, WGM = 8;

__host__ __device__ __forceinline__ int lds_byte(int r, int c) { const int st = (r >> 4) * 2 + (c >> 5), rr = r & 15, cc = c & 31, ob = rr * 64 + cc * 2; return st * 1024 + (ob ^ (((ob >> 9) & 1) << 5)); }
__host__ __device__ __forceinline__ void stage_rc(int b, int& R, int& C) { const int st = b / 1024, sb = b % 1024, swz = sb ^ (((sb >> 9) & 1) << 5); R = (st >> 1) * 16 + swz / 64; C = (st & 1) * 32 + (swz % 64) / 2; }
__host__ __device__ __forceinline__ int perm32(int rho) { const int n = rho >> 4, i = rho & 15; return 8 * (i >> 2) + 4 * n + (i & 3); }

struct Unit { int pm, pn; };
struct Gemm { const bf16_t* A; const bf16_t* Bt; int M, N, K; };

struct StaticOrder {
    int nM, nN, nwg, G, c, wgm;
    __host__ __device__ void init(int M, int N, int G_, int c_, int wgm_ = WGM) { nM = M / BM; nN = N / BM; nwg = nM * nN; G = G_; c = c_; wgm = wgm_; }
    __host__ __device__ bool next(int i, Unit& u) const {
        const long L = (long)i * G + c; if (L >= nwg) return false;
        int wgid = (int)L; { const int q = nwg / NXCD, r = nwg % NXCD, xcd = wgid % NXCD, off = wgid / NXCD; wgid = (xcd < r ? xcd * (q + 1) : r * (q + 1) + (xcd - r) * q) + off; }
        const int nig = wgm * nN, gid = wgid / nig, fm = gid * wgm, gsz = (nM - fm) < wgm ? (nM - fm) : wgm;
        u.pm = fm + ((wgid % nig) % gsz); u.pn = (wgid % nig) / gsz; if (gid & 1) u.pn = nN - 1 - u.pn;
        return true;
    }
    __device__ __forceinline__ void a_ready(const Unit&) const {}
    __device__ __forceinline__ void done(const Unit&) const {}
};

__device__ __forceinline__ unsigned cvt_pk_bf16(float lo, float hi) { unsigned r; asm volatile("v_cvt_pk_bf16_f32 %0, %1, %2" : "=v"(r) : "v"(lo), "v"(hi)); return r; }
typedef float f32x2 __attribute__((ext_vector_type(2)));
__device__ __forceinline__ int lane_id_asm() { int l; asm volatile("v_mbcnt_lo_u32_b32 %0, -1, 0\n\tv_mbcnt_hi_u32_b32 %0, -1, %0" : "=v"(l)); return l; }

__device__ __forceinline__ float silu_f(float z) { return z * __builtin_amdgcn_rcpf(1.f + __expf(-z)); }
__device__ __forceinline__ float sigm_f(float z) { return __builtin_amdgcn_rcpf(1.f + __expf(-z)); }
__device__ __forceinline__ u32x4 pack8(const f32x4 a, const f32x4 b) { u32x4 w; w.x = cvt_pk_bf16(a[0], a[1]); w.y = cvt_pk_bf16(a[2], a[3]); w.z = cvt_pk_bf16(b[0], b[1]); w.w = cvt_pk_bf16(b[2], b[3]); return w; }
__device__ __forceinline__ float bf_lo(unsigned u) { return __uint_as_float(u << 16); }
__device__ __forceinline__ float bf_hi(unsigned u) { return __uint_as_float(u & 0xffff0000u); }
__device__ __forceinline__ float sq4(const f32x4 x) { return (x[0] * x[0] + x[1] * x[1]) + (x[2] * x[2] + x[3] * x[3]); }
__device__ __forceinline__ float red_fq(float s) { s += __shfl_xor(s, 16); s += __shfl_xor(s, 32); return s; }

template <int ACT, bool NT = true> __device__ __forceinline__ void epi_plain(const f32x4 (&acc)[2][2][4][2], int row0, int wc, int fq, bf16_t* dst, int ldc, int col_base) {
#pragma unroll
    for (int ai = 0; ai < 2; ++ai)
#pragma unroll
        for (int m = 0; m < 4; ++m) { bf16_t* rowp = dst + (size_t)(row0 + ai * HALF + m * 16) * ldc + col_base + wc * 32 + 8 * fq;
#pragma unroll
            for (int bj = 0; bj < 2; ++bj) { f32x4 v0 = acc[ai][bj][m][0], v1 = acc[ai][bj][m][1];
                if (ACT == 1) {
#pragma unroll
                    for (int e = 0; e < 4; ++e) { v0[e] = silu_f(v0[e]); v1[e] = silu_f(v1[e]); } }
                if (ACT == 2) {
#pragma unroll
                    for (int e = 0; e < 4; ++e) { v0[e] = sigm_f(v0[e]); v1[e] = sigm_f(v1[e]); } }
                if (NT) __builtin_nontemporal_store(pack8(v0, v1), (u32x4*)(rowp + bj * HALF)); else *(u32x4*)(rowp + bj * HALF) = pack8(v0, v1); } }
}
template <int NBJ> __device__ __forceinline__ void epi_ssq(const f32x4 (&acc)[2][2][4][2], int row0, int fq, float* ssq, int ld, int slot) {
#pragma unroll
    for (int ai = 0; ai < 2; ++ai)
#pragma unroll
        for (int m = 0; m < 4; ++m) { float s = 0.f;
#pragma unroll
            for (int bj = 0; bj < NBJ; ++bj) s += sq4(acc[ai][bj][m][0]) + sq4(acc[ai][bj][m][1]);
            s = red_fq(s);
            if (fq == 0) ssq[(size_t)(row0 + ai * HALF + m * 16) * ld + slot] = s; }
}
template <int NSLOT> __device__ __forceinline__ float row_rs(const float* ssq, int row, float inv_n) { const float* p = ssq + (size_t)row * NSLOT; float s = 0.f;
#pragma unroll
    for (int k = 0; k < NSLOT; k += 4) { const f32x4 v = *(const f32x4*)(p + k); s += (v[0] + v[1]) + (v[2] + v[3]); }
    return rsqrtf(s * inv_n + EPS); }
template <int NSLOT> __device__ __forceinline__ void epi_heads(const f32x4 (&acc)[2][2][4][2], int row0, int wc, int fq, bf16_t* dst, int ldc, int head0, const float* w, float wscale, const float* ssq, float inv_n) {
    f32x4 wv[2][2];
#pragma unroll
    for (int bj = 0; bj < 2; ++bj)
#pragma unroll
        for (int n = 0; n < 2; ++n) wv[bj][n] = *(const f32x4*)(w + 32 * bj + 8 * fq + 4 * n) * wscale;
#pragma unroll
    for (int ai = 0; ai < 2; ++ai)
#pragma unroll
        for (int m = 0; m < 4; ++m) { float s = 0.f;
#pragma unroll
            for (int bj = 0; bj < 2; ++bj) s += sq4(acc[ai][bj][m][0]) + sq4(acc[ai][bj][m][1]);
            s = red_fq(s);
            const float r = NSLOT ? row_rs<NSLOT ? NSLOT : 4>(ssq, row0 + ai * HALF + m * 16, inv_n) : 1.f;
            const float f = r * rsqrtf(s * r * r * (1.f / 64.f) + EPS);
            bf16_t* rowp = dst + (size_t)(row0 + ai * HALF + m * 16) * ldc + (head0 + wc) * 64 + 8 * fq;
#pragma unroll
            for (int bj = 0; bj < 2; ++bj) __builtin_nontemporal_store(pack8(acc[ai][bj][m][0] * f * wv[bj][0], acc[ai][bj][m][1] * f * wv[bj][1]), (u32x4*)(rowp + 32 * bj));
            asm volatile("" ::: "memory"); }
}
__device__ __forceinline__ void rope_group(const f32x4 x0, const f32x4 x1, float r, const f32x4 w0, const f32x4 w1, const float* cosr, const float* sinr, int fq, float oscale, bf16_t* outp) {
    float s = red_fq(sq4(x0) + sq4(x1));
    const float f = r * rsqrtf(s * r * r * (1.f / 32.f) + EPS);
    const f32x4 y0 = x0 * f * w0, y1 = x1 * f * w1;
    f32x4 p0, p1;
#pragma unroll
    for (int e = 0; e < 4; ++e) { p0[e] = __shfl_xor(y0[e], 32); p1[e] = __shfl_xor(y1[e], 32); }
    const int i0 = 8 * (fq & 1);
    const f32x4 c0 = *(const f32x4*)(cosr + i0), c1 = *(const f32x4*)(cosr + i0 + 4), s0 = *(const f32x4*)(sinr + i0), s1 = *(const f32x4*)(sinr + i0 + 4);
    const float sg = (fq < 2) ? -oscale : oscale;
    const f32x4 o0 = y0 * c0 * oscale + p0 * s0 * sg, o1 = y1 * c1 * oscale + p1 * s1 * sg;
    __builtin_nontemporal_store(pack8(o0, o1), (u32x4*)outp);
    asm volatile("" ::: "memory");
}

__device__ __forceinline__ void epi_mgates(const f32x4 (&acc)[2][2][4][2], int row0, int wc, int fq, bf16_t* RA, bf16_t* SB, int c0) {
#pragma unroll
    for (int ai = 0; ai < 2; ++ai)
#pragma unroll
        for (int m = 0; m < 4; ++m) { const size_t off = (size_t)(row0 + ai * HALF + m * 16) * 1024 + c0 + wc * 32 + 8 * fq;
            f32x4 r0, r1, s0, s1;
#pragma unroll
            for (int e = 0; e < 4; ++e) {
                const float ea0 = 1.f + __builtin_amdgcn_exp2f(fminf(acc[ai][0][m][0][e], 115.f)), ea1 = 1.f + __builtin_amdgcn_exp2f(fminf(acc[ai][0][m][1][e], 115.f)), eb0 = 1.f + __builtin_amdgcn_exp2f(fminf(acc[ai][1][m][0][e], 115.f)), eb1 = 1.f + __builtin_amdgcn_exp2f(fminf(acc[ai][1][m][1][e], 115.f));
                r0[e] = eb0 * __builtin_amdgcn_rcpf(ea0); r1[e] = eb1 * __builtin_amdgcn_rcpf(ea1); s0[e] = __builtin_amdgcn_rcpf(eb0); s1[e] = __builtin_amdgcn_rcpf(eb1); }
            __builtin_nontemporal_store(pack8(r0, r1), (u32x4*)(RA + off)); __builtin_nontemporal_store(pack8(s0, s1), (u32x4*)(SB + off)); }
}
struct EpiIn {
    static constexpr bool PERM = true, AFTER_DRAIN = false; static constexpr int MID_T = 0;
    unsigned char* ws;
    __device__ __forceinline__ void operator()(const f32x4 (&acc)[2][2][4][2], const Unit& u, int wr, int wc, int fr, int fq) const {
        { const int l_ = lane_id_asm(); fr = l_ & 15; fq = l_ >> 4; }
        const int pn = u.pn, row0 = u.pm * BM + wr * 64 + fr;
        unsigned long long z_ = 0; asm volatile("" : "+s"(z_)); unsigned char* w_ = ws + z_;
        bf16_t *QB = (bf16_t*)(w_ + WSO_QB), *KB = (bf16_t*)(w_ + WSO_KB), *VB = (bf16_t*)(w_ + WSO_VB), *GA = (bf16_t*)(w_ + WSO_GA), *GB = (bf16_t*)(w_ + WSO_GB), *RA = (bf16_t*)(w_ + WSO_RA), *SB = (bf16_t*)(w_ + WSO_SB),
               *CKV = (bf16_t*)(w_ + WSO_CKV), *CQ = (bf16_t*)(w_ + WSO_CQ), *KROPE = (bf16_t*)(w_ + WSO_KROPE);
        float *LOGF = (float*)(w_ + WSO_LOGF), *SSQ_Q = (float*)(w_ + WSO_SSQQ), *SSQ_KV = (float*)(w_ + WSO_SSQKV);
        const float *PAR = (const float*)(w_ + WSO_PAR), *qn_b = PAR + PAR_QNB, *kn_b = PAR + PAR_KNB, *kn_rope = PAR + PAR_KNROPE, *b_f = PAR + PAR_BF, *COS = (const float*)(w_ + WSO_COS), *SIN = (const float*)(w_ + WSO_SIN);
        if (pn < 2) epi_heads<0>(acc, row0, wc, fq, QB, 512, pn * 4, qn_b, C2B, nullptr, 0.f);
        else if (pn < 4) epi_heads<0>(acc, row0, wc, fq, KB, 512, (pn - 2) * 4, kn_b, 1.f, nullptr, 0.f);
        else if (pn < 6) epi_plain<0>(acc, row0, wc, fq, VB, 512, (pn - 4) * 256);
        else if (pn < 8) epi_plain<1>(acc, row0, wc, fq, GA, 512, (pn - 6) * 256);
        else if (pn < 10) epi_plain<1>(acc, row0, wc, fq, GB, 512, (pn - 8) * 256);
        else if (pn < 18) epi_mgates(acc, row0, wc, fq, RA, SB, (pn - 10) * 128);
        else if (pn == 18) { epi_plain<0, false>(acc, row0, wc, fq, CKV, 256, 0); epi_ssq<2>(acc, row0, fq, SSQ_KV, 4, wc); }
        else if (pn == 19) { epi_plain<0, false>(acc, row0, wc, fq, CQ, 384, 0); epi_ssq<2>(acc, row0, fq, SSQ_Q, 8, wc); }
        else {
            epi_ssq<1>(acc, row0, fq, SSQ_Q, 8, 4 + wc);
#pragma unroll
            for (int ai = 0; ai < 2; ++ai)
#pragma unroll
                for (int m = 0; m < 4; ++m) *(u32x4*)(CQ + (size_t)(row0 + ai * HALF + m * 16) * 384 + 256 + wc * 32 + 8 * fq) = pack8(acc[ai][0][m][0], acc[ai][0][m][1]);
            if (wc == 0) {
                const f32x4 w0 = *(const f32x4*)(kn_rope + 8 * fq), w1 = *(const f32x4*)(kn_rope + 8 * fq + 4);
#pragma unroll
                for (int ai = 0; ai < 2; ++ai)
#pragma unroll
                    for (int m = 0; m < 4; ++m) { const size_t row = (size_t)(row0 + ai * HALF + m * 16);
                        rope_group(acc[ai][1][m][0], acc[ai][1][m][1], 1.f, w0, w1, COS + row * 16, SIN + row * 16, fq, 1.f, KROPE + row * 32 + 8 * fq); }
            } else if (wc == 1) {
                if (fq == 0) { const f32x4 b0 = *(const f32x4*)(b_f), b1 = *(const f32x4*)(b_f + 4);
#pragma unroll
                    for (int ai = 0; ai < 2; ++ai)
#pragma unroll
                        for (int m = 0; m < 4; ++m) { const size_t row = (size_t)(row0 + ai * HALF + m * 16); f32x4 z0 = acc[ai][1][m][0] + b0, z1 = acc[ai][1][m][1] + b1;
#pragma unroll
                            for (int e = 0; e < 4; ++e) { z0[e] = fminf(z0[e], 0.f) - log1pf(expf(-fabsf(z0[e]))); z1[e] = fminf(z1[e], 0.f) - log1pf(expf(-fabsf(z1[e]))); }
                            *(f32x4*)(LOGF + row * 8) = z0; *(f32x4*)(LOGF + row * 8 + 4) = z1; } }
            }
        }
    }
};
struct EpiQup {
    static constexpr bool PERM = true, AFTER_DRAIN = false; static constexpr int MID_T = 0;
    unsigned char* ws;
    __device__ __forceinline__ void operator()(const f32x4 (&acc)[2][2][4][2], const Unit& u, int wr, int wc, int fr, int fq) const {
        { const int l_ = lane_id_asm(); fr = l_ & 15; fq = l_ >> 4; }
        const int pn = u.pn, row0 = u.pm * BM + wr * 64 + fr;
        unsigned long long z_ = 0; asm volatile("" : "+s"(z_)); unsigned char* w_ = ws + z_;
        bf16_t *QAN = (bf16_t*)(w_ + WSO_QAN), *QAR = (bf16_t*)(w_ + WSO_QAR);
        const float *SSQ_Q = (const float*)(w_ + WSO_SSQQ), *PAR = (const float*)(w_ + WSO_PAR), *qn_nope = PAR + PAR_QNNOPE, *qn_rope = PAR + PAR_QNROPE, *COS = (const float*)(w_ + WSO_COS), *SIN = (const float*)(w_ + WSO_SIN);
        if (pn < 2) epi_heads<8>(acc, row0, wc, fq, QAN, 512, pn * 4, qn_nope, C2A, SSQ_Q, 1.f / 384.f);
        else { const f32x4 w0 = *(const f32x4*)(qn_rope + 8 * fq), w1 = *(const f32x4*)(qn_rope + 8 * fq + 4);
#pragma unroll
            for (int ai = 0; ai < 2; ++ai)
#pragma unroll
                for (int m = 0; m < 4; ++m) { const size_t row = (size_t)(row0 + ai * HALF + m * 16); const float rsr = row_rs<8>(SSQ_Q, (int)row, 1.f / 384.f);
#pragma unroll
                    for (int bj = 0; bj < 2; ++bj) rope_group(acc[ai][bj][m][0], acc[ai][bj][m][1], rsr, w0, w1, COS + row * 16, SIN + row * 16, fq, C2A, QAR + row * 256 + (4 * bj + wc) * 32 + 8 * fq); } }
    }
};
struct EpiKVup {
    static constexpr bool PERM = true, AFTER_DRAIN = false; static constexpr int MID_T = 0;
    unsigned char* ws;
    __device__ __forceinline__ void operator()(const f32x4 (&acc)[2][2][4][2], const Unit& u, int wr, int wc, int fr, int fq) const {
        { const int l_ = lane_id_asm(); fr = l_ & 15; fq = l_ >> 4; }
        const int pn = u.pn, row0 = u.pm * BM + wr * 64 + fr;
        unsigned long long z_ = 0; asm volatile("" : "+s"(z_)); unsigned char* w_ = ws + z_;
        bf16_t *KAN = (bf16_t*)(w_ + WSO_KAN), *VA = (bf16_t*)(w_ + WSO_VA);
        const float *SSQ_KV = (const float*)(w_ + WSO_SSQKV), *kn_nope = (const float*)(w_ + WSO_PAR) + PAR_KNNOPE;
        if (pn < 2) epi_heads<4>(acc, row0, wc, fq, KAN, 512, pn * 4, kn_nope, 1.f, SSQ_KV, 1.f / 256.f);
        else {
#pragma unroll
            for (int ai = 0; ai < 2; ++ai)
#pragma unroll
                for (int m = 0; m < 4; ++m) { bf16_t* rowp = VA + (size_t)(row0 + ai * HALF + m * 16) * 512 + (pn - 2) * 256 + wc * 32 + 8 * fq; const float r = row_rs<4>(SSQ_KV, row0 + ai * HALF + m * 16, 1.f / 256.f);
#pragma unroll
                    for (int bj = 0; bj < 2; ++bj) __builtin_nontemporal_store(pack8(acc[ai][bj][m][0] * r, acc[ai][bj][m][1] * r), (u32x4*)(rowp + bj * HALF));
                    asm volatile("" ::: "memory"); } }
    }
};
struct EpiMerge {
    static constexpr bool PERM = true, AFTER_DRAIN = false; static constexpr int MID_T = 8;
    unsigned char* ws;
#define EM_LOAD(buf, P, gi) do { const size_t off_ = (size_t)(row0 + ((gi) >> 2) * HALF + ((gi) & 3) * 16) * 1024 + col0; buf[0] = *(const u32x4*)(P + off_); buf[1] = *(const u32x4*)(P + off_ + HALF); } while (0)
#define EM_MUL(v0, v1, s) do { v0[0] *= bf_lo(s.x); v0[1] *= bf_hi(s.x); v0[2] *= bf_lo(s.y); v0[3] *= bf_hi(s.y); v1[0] *= bf_lo(s.z); v1[1] *= bf_hi(s.z); v1[2] *= bf_lo(s.w); v1[3] *= bf_hi(s.w); } while (0)
    __device__ __forceinline__ void mid(f32x4 (&acc)[2][2][4][2], const Unit& u, int wr, int wc, int fr, int fq) const {
        { const int l_ = lane_id_asm(); fr = l_ & 15; fq = l_ >> 4; }
        unsigned long long z_ = 0; asm volatile("" : "+s"(z_)); const bf16_t* RA = (const bf16_t*)(ws + z_ + WSO_RA);
        const int row0 = u.pm * BM + wr * 64 + fr, col0 = u.pn * BM + wc * 32 + 8 * fq;
        u32x4 sa[2], sb[2];
#define EM_MIDAPPLY(buf, gi) do { _Pragma("unroll") for (int bj = 0; bj < 2; ++bj) EM_MUL(acc[(gi) >> 2][bj][(gi) & 3][0], acc[(gi) >> 2][bj][(gi) & 3][1], buf[bj]); } while (0)
        u32x4 sq[8][2];
#pragma unroll
        for (int gi = 0; gi < 8; ++gi) EM_LOAD(sq[gi], RA, gi);
#pragma unroll
        for (int gi = 0; gi < 8; ++gi) EM_MIDAPPLY(sq[gi], gi);
#undef EM_MIDAPPLY
    }
    __device__ __forceinline__ void operator()(const f32x4 (&acc)[2][2][4][2], const Unit& u, int wr, int wc, int fr, int fq) const {
        { const int l_ = lane_id_asm(); fr = l_ & 15; fq = l_ >> 4; }
        unsigned long long z_ = 0; asm volatile("" : "+s"(z_)); unsigned char* w_ = ws + z_; const bf16_t* SB = (const bf16_t*)(w_ + WSO_SB); bf16_t* T = (bf16_t*)(w_ + WSO_MERGED);
        const int row0 = u.pm * BM + wr * 64 + fr, col0 = u.pn * BM + wc * 32 + 8 * fq;
        u32x4 sa[2], sb[2];
#define EM_OUT(buf, gi) do { const size_t off_ = (size_t)(row0 + ((gi) >> 2) * HALF + ((gi) & 3) * 16) * 1024 + col0; \
        _Pragma("unroll") for (int bj = 0; bj < 2; ++bj) { f32x4 v0 = acc[(gi) >> 2][bj][(gi) & 3][0], v1 = acc[(gi) >> 2][bj][(gi) & 3][1]; EM_MUL(v0, v1, buf[bj]); __builtin_nontemporal_store(pack8(v0, v1), (u32x4*)(T + off_ + bj * HALF)); } } while (0)
        u32x4 sq[8][2];
#pragma unroll
        for (int gi = 0; gi < 8; ++gi) EM_LOAD(sq[gi], SB, gi);
#pragma unroll
        for (int gi = 0; gi < 8; ++gi) EM_OUT(sq[gi], gi);
#undef EM_OUT
    }
#undef EM_LOAD
#undef EM_MUL
};
struct PanelOrder {
    int c, G, nN, nM;
    __host__ __device__ void init(int M, int N, int G_, int c_) { nM = M / BM; nN = N / BM; G = G_; c = c_; }
    __host__ __device__ bool next(int i, Unit& u) const { const int pm = c + (i / nN) * G; if (pm >= nM) return false; u.pm = pm; u.pn = i % nN; return true; }
    __device__ __forceinline__ void a_ready(const Unit&) const {}
    __device__ __forceinline__ void done(const Unit&) const {}
};
template <int GS> struct GroupOrder {
    int base, j;
    __host__ __device__ void init(int vcu) { base = (vcu / GS) * GS; j = vcu % GS; }
    __host__ __device__ bool next(int i, Unit& u) const { if (i >= 4) return false; u.pm = base + i * (GS / 4) + (j >> 2); u.pn = j & 3; return true; }
    __device__ __forceinline__ void a_ready(const Unit&) const {}
    __device__ __forceinline__ void done(const Unit&) const {}
};
struct EpiOut {
    static constexpr bool PERM = false, AFTER_DRAIN = false; static constexpr int MID_T = 0;
    const float* X; float* O; const float* GATE;
    __device__ __forceinline__ void operator()(const f32x4 (&acc)[2][2][4][2], const Unit& u, int wr, int wc, int fr, int fq) const {
        { const int l_ = lane_id_asm(); fr = l_ & 15; fq = l_ >> 4; }
        const int row0 = u.pm * BM + wr * 64 + fr, col0 = u.pn * BM + wc * 32 + 4 * fq; const float* g = GATE + (size_t)(u.pm >> 3) * 3072 + col0;
        f32x4 gv[2][2];
#pragma unroll
        for (int bj = 0; bj < 2; ++bj)
#pragma unroll
            for (int n = 0; n < 2; ++n) gv[bj][n] = *(const f32x4*)(g + bj * HALF + n * 16);
        f32x4 xa[2][2], xb[2][2];
#define EO_LOAD(buf, gi) do { const size_t off_ = (size_t)(row0 + ((gi) >> 2) * HALF + ((gi) & 3) * 16) * 1024 + col0; \
        _Pragma("unroll") for (int bj = 0; bj < 2; ++bj) _Pragma("unroll") for (int n = 0; n < 2; ++n) buf[bj][n] = *(const f32x4*)(X + off_ + bj * HALF + n * 16); } while (0)
#define EO_STORE(buf, gi) do { const size_t off_ = (size_t)(row0 + ((gi) >> 2) * HALF + ((gi) & 3) * 16) * 1024 + col0; \
        _Pragma("unroll") for (int bj = 0; bj < 2; ++bj) _Pragma("unroll") for (int n = 0; n < 2; ++n) __builtin_nontemporal_store(buf[bj][n] + gv[bj][n] * acc[(gi) >> 2][bj][(gi) & 3][n], (f32x4*)(O + off_ + bj * HALF + n * 16)); } while (0)
        EO_LOAD(xa, 0);
        EO_LOAD(xb, 1); EO_STORE(xa, 0);
        EO_LOAD(xa, 2); EO_STORE(xb, 1);
        EO_LOAD(xb, 3); EO_STORE(xa, 2);
        EO_LOAD(xa, 4); EO_STORE(xb, 3);
        EO_LOAD(xb, 5); EO_STORE(xa, 4);
        EO_LOAD(xa, 6); EO_STORE(xb, 5);
        EO_LOAD(xb, 7); EO_STORE(xa, 6);
        EO_STORE(xb, 7);
#undef EO_LOAD
#undef EO_STORE
    }
};

template <class Epi, class Sched, bool ALIGN_EPI = false, bool SP2 = false, int UNR = 1>
__device__ __forceinline__ void gemm_phase(PG8_LAS unsigned char* lds, const Gemm g, const Sched& S, const Epi& E, int wave_in  ) {
    const int lane = lane_id_asm(), wid = wave_in, tid = wid * 64 + lane,
        wr = wid >> 2, wc = wid & 3, fr = lane & 15, fq = lane >> 4;
    const int K = g.K, nt = K / BK;
    unsigned voffA[2], voffB[2];
#pragma unroll
    for (int i = 0; i < 2; ++i) { int R, C; stage_rc(tid * 16 + i * 8192, R, C); const int Rb = Epi::PERM ? ((R & ~31) + perm32(R & 31)) : R;
        voffA[i] = (unsigned)(R * K + C) * 2u; voffB[i] = (unsigned)(Rb * K + C) * 2u; }
    const size_t kstep = (size_t)(BK * 2);
    const size_t hstep = (size_t)HALF * K * 2;
    const size_t tstep = 2 * hstep;
    const unsigned ldsw = (unsigned)wid * 1024u;
    const int aoff = lds_byte(wr * 64 + fr, fq * 8), boff = lds_byte(wc * 32 + fr, fq * 8);
#define PG8_SA(b, h) (((b) * 2 + (h)) * HTB)
#define PG8_SB(b, h) ((4 + (b) * 2 + (h)) * HTB)
#define PG8_STAGE(bufoff, gbase, voff) do { _Pragma("unroll") for (int _i = 0; _i < 2; ++_i) \
        __builtin_amdgcn_global_load_lds((const unsigned*)((const char*)(gbase) + (voff)[_i]), (PG8_LAS unsigned*)(lds + (bufoff) + ldsw + _i * 8192), 16, 0, 0); } while (0)
#define PG8_LDA(dst, b, h) do { _Pragma("unroll") for (int m = 0; m < 4; ++m) _Pragma("unroll") for (int k = 0; k < 2; ++k) dst[m][k] = *(const PG8_LAS bf16x8*)(lds + PG8_SA(b, h) + aoff + m * 2048 + k * 1024); } while (0)
#define PG8_LDB(dst, b, h) do { _Pragma("unroll") for (int n = 0; n < 2; ++n) _Pragma("unroll") for (int k = 0; k < 2; ++k) dst[n][k] = *(const PG8_LAS bf16x8*)(lds + PG8_SB(b, h) + boff + n * 2048 + k * 1024); } while (0)
#define PG8_MMA(ai, bj, At, Bt) do { __builtin_amdgcn_s_setprio(1); _Pragma("unroll") for (int m = 0; m < 4; ++m) _Pragma("unroll") for (int n = 0; n < 2; ++n) _Pragma("unroll") for (int k = 0; k < 2; ++k) \
        acc[ai][bj][m][n] = __builtin_amdgcn_mfma_f32_16x16x32_bf16(Bt[n][k], At[m][k], acc[ai][bj][m][n], 0, 0, 0); __builtin_amdgcn_s_setprio(0); } while (0)
#define PG8_WAIT_V(n) asm volatile("s_waitcnt vmcnt(" #n ")" ::: "memory")
#define PG8_WAIT_L(n) asm volatile("s_waitcnt lgkmcnt(" #n ")" ::: "memory")
#define PG8_BAR __builtin_amdgcn_s_barrier()
#define PG8_SCHED __builtin_amdgcn_sched_barrier(0)
    Unit cur, nxt; int ui = 0;
    if (!S.next(0, cur)) return;
    f32x4 acc[2][2][4][2];
#pragma unroll
    for (int a = 0; a < 2; ++a)
#pragma unroll
        for (int b = 0; b < 2; ++b)
#pragma unroll
            for (int m = 0; m < 4; ++m)
#pragma unroll
                for (int n = 0; n < 2; ++n) acc[a][b][m][n] = (f32x4){0.f, 0.f, 0.f, 0.f};
    bf16x8 At[4][2], B0[2][2], B1[2][2];
    const char* cA = (const char*)g.A + (size_t)cur.pm * tstep; const char* cB = (const char*)g.Bt + (size_t)cur.pn * tstep;
    S.a_ready(cur);
    if constexpr (SP2) {
        PG8_STAGE(PG8_SB(0, 0), cB, voffB); PG8_STAGE(PG8_SB(0, 1), cB + hstep, voffB); PG8_STAGE(PG8_SA(0, 0), cA, voffA); PG8_STAGE(PG8_SA(0, 1), cA + hstep, voffA);
        if (wr == 1) PG8_BAR;
        PG8_WAIT_V(2); PG8_BAR;
        PG8_STAGE(PG8_SB(1, 0), cB + kstep, voffB); PG8_STAGE(PG8_SA(1, 0), cA + kstep, voffA); PG8_STAGE(PG8_SB(1, 1), cB + hstep + kstep, voffB);
        PG8_WAIT_V(6); PG8_BAR;
    } else {
        PG8_STAGE(PG8_SB(0, 0), cB, voffB); PG8_STAGE(PG8_SA(0, 0), cA, voffA); PG8_STAGE(PG8_SB(0, 1), cB + hstep, voffB); PG8_STAGE(PG8_SA(0, 1), cA + hstep, voffA);
        if (wr == 1) PG8_BAR;
        PG8_WAIT_V(4); PG8_BAR;
        PG8_STAGE(PG8_SB(1, 0), cB + kstep, voffB); PG8_STAGE(PG8_SA(1, 0), cA + kstep, voffA); PG8_STAGE(PG8_SB(1, 1), cB + hstep + kstep, voffB);
        PG8_WAIT_V(6); PG8_BAR;
    }
    for (;;) {
        const bool has_next = S.next(ui + 1, nxt);
        const char* nA = has_next ? (const char*)g.A + (size_t)nxt.pm * tstep : cA; const char* nB = has_next ? (const char*)g.Bt + (size_t)nxt.pn * tstep : cB;
        _Pragma("clang loop unroll_count(UNR)")
        for (int t = 0; t < nt; t += 2) {
            const bool last = (t == nt - 2);
            const char* a1 = cA + (size_t)(t + 1) * kstep;
            const char* a2 = last ? nA : cA + (size_t)(t + 2) * kstep; const char* b2 = last ? nB : cB + (size_t)(t + 2) * kstep;
            const char* a3 = a2 + kstep; const char* b3 = b2 + kstep;
            if constexpr (Epi::MID_T > 0) { if (t == Epi::MID_T) E.mid(acc, cur, wr, wc, fr, fq); }
            if (last && has_next) S.a_ready(nxt);
            if constexpr (SP2) {
            PG8_LDB(B0, 0, 0); PG8_LDB(B1, 0, 1); PG8_SCHED; PG8_LDA(At, 0, 0); PG8_STAGE(PG8_SA(1, 1), a1 + hstep, voffA);
            PG8_WAIT_V(8); PG8_WAIT_L(0); PG8_BAR; PG8_MMA(0, 0, At, B0); PG8_MMA(0, 1, At, B1); PG8_BAR; PG8_SCHED;
            PG8_LDA(At, 0, 1); PG8_STAGE(PG8_SB(0, 0), b2, voffB); PG8_STAGE(PG8_SB(0, 1), b2 + hstep, voffB); PG8_STAGE(PG8_SA(0, 0), a2, voffA);
            PG8_WAIT_V(8); PG8_WAIT_L(0); PG8_BAR; PG8_MMA(1, 0, At, B0); PG8_MMA(1, 1, At, B1); PG8_BAR; PG8_SCHED;
            PG8_LDB(B0, 1, 0); PG8_LDB(B1, 1, 1); PG8_SCHED; PG8_LDA(At, 1, 0); PG8_STAGE(PG8_SA(0, 1), a2 + hstep, voffA);
            PG8_WAIT_V(8); PG8_WAIT_L(0); PG8_BAR; PG8_MMA(0, 0, At, B0); PG8_MMA(0, 1, At, B1); PG8_BAR; PG8_SCHED;
            PG8_LDA(At, 1, 1); PG8_STAGE(PG8_SB(1, 0), b3, voffB); PG8_STAGE(PG8_SB(1, 1), b3 + hstep, voffB); PG8_STAGE(PG8_SA(1, 0), a3, voffA);
            PG8_WAIT_V(8); PG8_WAIT_L(0); PG8_BAR; PG8_MMA(1, 0, At, B0); PG8_MMA(1, 1, At, B1); PG8_BAR; PG8_SCHED;
            } else {
            PG8_LDB(B0, 0, 0); PG8_SCHED; PG8_LDA(At, 0, 0); PG8_STAGE(PG8_SA(1, 1), a1 + hstep, voffA);
            PG8_WAIT_L(8); PG8_BAR; PG8_WAIT_L(0); PG8_MMA(0, 0, At, B0); PG8_BAR; PG8_SCHED;
            PG8_LDB(B1, 0, 1); PG8_STAGE(PG8_SB(0, 0), b2, voffB);
            PG8_BAR; PG8_WAIT_L(0); PG8_MMA(0, 1, At, B1); PG8_BAR;
            PG8_LDA(At, 0, 1); PG8_STAGE(PG8_SA(0, 0), a2, voffA);
            PG8_BAR; PG8_WAIT_L(0); PG8_MMA(1, 0, At, B0); PG8_BAR; PG8_SCHED;
            PG8_STAGE(PG8_SB(0, 1), b2 + hstep, voffB);
            PG8_WAIT_V(6); PG8_BAR; PG8_MMA(1, 1, At, B1); PG8_BAR;
            PG8_LDB(B0, 1, 0); PG8_SCHED; PG8_LDA(At, 1, 0); PG8_STAGE(PG8_SA(0, 1), a2 + hstep, voffA);
            PG8_WAIT_L(8); PG8_BAR; PG8_WAIT_L(0); PG8_MMA(0, 0, At, B0); PG8_BAR; PG8_SCHED;
            PG8_LDB(B1, 1, 1); PG8_STAGE(PG8_SB(1, 0), b3, voffB);
            PG8_BAR; PG8_WAIT_L(0); PG8_MMA(0, 1, At, B1); PG8_BAR;
            PG8_LDA(At, 1, 1); PG8_STAGE(PG8_SA(1, 0), a3, voffA);
            PG8_BAR; PG8_WAIT_L(0); PG8_MMA(1, 0, At, B0); PG8_BAR; PG8_SCHED;
            PG8_STAGE(PG8_SB(1, 1), b3 + hstep, voffB);
            PG8_WAIT_V(6); PG8_BAR; PG8_MMA(1, 1, At, B1); PG8_BAR;
            }
        }
        if constexpr (ALIGN_EPI) { if (wr == 0) PG8_BAR; }
        if constexpr (!Epi::AFTER_DRAIN) { E(acc, cur, wr, wc, fr, fq); S.done(cur); }
        if (!has_next) break;
#pragma unroll
        for (int a = 0; a < 2; ++a)
#pragma unroll
            for (int b = 0; b < 2; ++b)
#pragma unroll
                for (int m = 0; m < 4; ++m)
#pragma unroll
                    for (int n = 0; n < 2; ++n) acc[a][b][m][n] = (f32x4){0.f, 0.f, 0.f, 0.f};
        cur = nxt; cA = nA; cB = nB; ++ui;
        if constexpr (ALIGN_EPI) { if (wr == 1) PG8_BAR; }
    }
    PG8_WAIT_V(0);
    if constexpr (!ALIGN_EPI) { if (wr == 0) PG8_BAR; }
    PG8_BAR;
    if constexpr (Epi::AFTER_DRAIN) { E.fused(acc, cur, wr, wc, fr, fq, lds, wid, lane); S.done(cur); }
#undef PG8_SA
#undef PG8_SB
#undef PG8_STAGE
#undef PG8_LDA
#undef PG8_LDB
#undef PG8_MMA
#undef PG8_WAIT_V
#undef PG8_WAIT_L
#undef PG8_BAR
#undef PG8_SCHED
}
}
namespace att {
#define LAS3 __attribute__((address_space(3)))
using bf16x8 = __attribute__((ext_vector_type(8))) short;
using s16x4 = __attribute__((ext_vector_type(4))) short;
using f32x16 = __attribute__((ext_vector_type(16))) float;
using f32x4 = __attribute__((ext_vector_type(4))) float;
using u32x4 = __attribute__((ext_vector_type(4))) unsigned;
constexpr int NW = 8, QBLK = 32, QB = 256, KVBLK = 64;
constexpr int LDS_K = 0, LDS_V = 12288, LDS_CUM = 20480, LDS_WS = 28672, LDS_TMP = 30720, LDS_OST = 31744, LDS_BYTES = LDS_OST + NW * 8192;
__device__ __forceinline__ int crow(int r, int hi) { return (r & 3) + 8 * (r >> 2) + 4 * hi; }
typedef float f32x2_t __attribute__((ext_vector_type(2))); typedef __bf16 bf16x2_t __attribute__((ext_vector_type(2)));
__device__ __forceinline__ unsigned cvtpk_s(float lo, float hi) { f32x2_t v = {lo, hi}; bf16x2_t b = __builtin_convertvector(v, bf16x2_t); return __builtin_bit_cast(unsigned, b); }
__device__ __forceinline__ float bf_lo(unsigned u) { return __uint_as_float(u << 16); }
__device__ __forceinline__ float bf_hi(unsigned u) { return __uint_as_float(u & 0xffff0000u); }
#define ATT_SBAR() __builtin_amdgcn_sched_barrier(0)
__device__ __forceinline__ float rowmax(const f32x16& p0, const f32x16& p1) {
    float a = fmaxf(p0[0], p1[0]);
#pragma unroll
    for (int r = 1; r < 16; ++r) a = fmaxf(a, fmaxf(p0[r], p1[r]));
    auto rr = __builtin_amdgcn_permlane32_swap(__float_as_uint(a), __float_as_uint(a), false, false);
    return fmaxf(__uint_as_float(rr[0]), __uint_as_float(rr[1]));
}
__device__ __forceinline__ void pv(f32x16* o, int vb, bf16x8 pa0, bf16x8 pa1, bf16x8 pa2, bf16x8 pa3) {
#pragma unroll
    for (int d0 = 0; d0 < 2; ++d0) { s16x4 lo[4], hi[4];
#pragma unroll
        for (int ks = 0; ks < 4; ++ks) {
            asm volatile("ds_read_b64_tr_b16 %0,%1 offset:%c2" : "=&v"(lo[ks]) : "v"(vb), "i"(d0 * 4096 + ks * 1024) : "memory");
            asm volatile("ds_read_b64_tr_b16 %0,%1 offset:%c2" : "=&v"(hi[ks]) : "v"(vb), "i"(d0 * 4096 + ks * 1024 + 512) : "memory"); }
        asm volatile("s_waitcnt lgkmcnt(0)" ::: "memory"); ATT_SBAR();
#define ATT_PK(k) (bf16x8){lo[k][0], lo[k][1], lo[k][2], lo[k][3], hi[k][0], hi[k][1], hi[k][2], hi[k][3]}
        o[d0] = __builtin_amdgcn_mfma_f32_32x32x16_bf16(pa0, ATT_PK(0), o[d0], 0, 0, 0);
        o[d0] = __builtin_amdgcn_mfma_f32_32x32x16_bf16(pa1, ATT_PK(1), o[d0], 0, 0, 0);
        o[d0] = __builtin_amdgcn_mfma_f32_32x32x16_bf16(pa2, ATT_PK(2), o[d0], 0, 0, 0);
        o[d0] = __builtin_amdgcn_mfma_f32_32x32x16_bf16(pa3, ATT_PK(3), o[d0], 0, 0, 0);
#undef ATT_PK
    }
}
struct Tensors {
    const unsigned short *Q1, *Q2, *K1, *K2, *V, *G; unsigned short* Y; int ypitch;
};
template <bool RAW = false> __device__ __forceinline__ void fox_cum(const float* LOGF, int b, int h, LAS3 float* cum, LAS3 float* tmp8, int wid  ) {
    const int lane = pg8::lane_id_asm(), tid = wid * 64 + lane;
    const float* src = LOGF + ((size_t)b * SEQ + 4 * tid) * 8 + h;
    const float v0 = src[0], v1 = src[8], v2 = src[16], v3 = src[24];
    const float p0 = v0, p1 = p0 + v1, p2 = p1 + v2, p3 = p2 + v3;
    float incl = p3;
#pragma unroll
    for (int off = 1; off < 64; off <<= 1) { const float t = __int_as_float(__builtin_amdgcn_ds_bpermute((lane - off) * 4, __float_as_int(incl))); if (lane >= off) incl += t; }
    if (lane == 63) tmp8[wid] = incl;
    if (RAW) asm volatile("s_waitcnt lgkmcnt(0)\n\ts_barrier" ::: "memory"); else __syncthreads();
    float base = incl - p3;
    for (int w = 0; w < wid; ++w) base += tmp8[w];
    cum[4 * tid + 0] = (base + p0) * LOG2E; cum[4 * tid + 1] = (base + p1) * LOG2E; cum[4 * tid + 2] = (base + p2) * LOG2E; cum[4 * tid + 3] = (base + p3) * LOG2E;
    if (RAW) asm volatile("s_waitcnt lgkmcnt(0)\n\ts_barrier" ::: "memory"); else __syncthreads();
}
template <int MODE> __device__ __forceinline__ void attn_unit(int b, int h, int qb, const Tensors& T, LAS3 unsigned char* lds, int wid  ) {
    constexpr int NQ = MODE ? 6 : 4;
    const int lane = pg8::lane_id_asm(), r32 = lane & 31, hi = lane >> 5;
    const size_t rowbase = (size_t)b * SEQ; const int q0 = qb * QB, NT = (q0 + QB) / KVBLK;
    const int qpos = q0 + wid * QBLK + r32;
    LAS3 float* wsf = (LAS3 float*)(lds + LDS_WS) + wid * 64;
    LAS3 const float* cum = (LAS3 const float*)(lds + LDS_CUM);
    bf16x8 qr[NQ];
#pragma unroll
    for (int d0 = 0; d0 < 4; ++d0) qr[d0] = *(const bf16x8*)(T.Q1 + (rowbase + qpos) * 512 + h * 64 + d0 * 16 + hi * 8);
    if (MODE) {
#pragma unroll
        for (int d0 = 0; d0 < 2; ++d0) qr[4 + d0] = *(const bf16x8*)(T.Q2 + (rowbase + qpos) * 256 + h * 32 + d0 * 16 + hi * 8); }
    float m_run = -INFINITY, l_run = 0.f; f32x16 o[2]; o[0] = f32x16{}; o[1] = f32x16{};
    const float cq = MODE ? 0.f : cum[qpos];
    const int vb0 = (int)(unsigned)(uintptr_t)(lds + LDS_V) + ((lane >> 4) & 1) * 32 + (lane & 3) * 8 + (4 * hi + ((lane & 15) >> 2)) * 64;
    for (int t = 0; t < NT; ++t) {
        __syncthreads();
        { const size_t krow = rowbase + (size_t)t * KVBLK;
          const u32x4 kv = *(const u32x4*)(T.K1 + (krow + lane) * 512 + h * 64 + wid * 8);
          const u32x4 vv = *(const u32x4*)(T.V + (krow + 16 * (wid & 3) + (lane >> 2)) * 512 + h * 64 + (wid >> 2) * 32 + (lane & 3) * 8);
          *(LAS3 u32x4*)(lds + LDS_K + wid * 1024 + lane * 16) = kv;
          *(LAS3 u32x4*)(lds + LDS_V + wid * 1024 + lane * 16) = vv;
          if (MODE && wid < 4) { const u32x4 k2 = *(const u32x4*)(T.K2 + (krow + lane) * 32 + wid * 8); *(LAS3 u32x4*)(lds + LDS_K + (8 + wid) * 1024 + lane * 16) = k2; } }
        __syncthreads();
        f32x16 p0 = f32x16{}, p1 = f32x16{};
#pragma unroll
        for (int d0 = 0; d0 < NQ; ++d0) {
            const bf16x8 b0 = *(LAS3 const bf16x8*)(lds + LDS_K + (2 * d0 + hi) * 1024 + r32 * 16);
            const bf16x8 b1 = *(LAS3 const bf16x8*)(lds + LDS_K + (2 * d0 + hi) * 1024 + 512 + r32 * 16);
            p0 = __builtin_amdgcn_mfma_f32_32x32x16_bf16(b0, qr[d0], p0, 0, 0, 0); p1 = __builtin_amdgcn_mfma_f32_32x32x16_bf16(b1, qr[d0], p1, 0, 0, 0); }
        if (MODE == 0) {
            const int kb = t * KVBLK + 4 * hi;
#pragma unroll
            for (int g = 0; g < 4; ++g) { const f32x4 c0 = *(LAS3 const f32x4*)(cum + kb + 8 * g), c1 = *(LAS3 const f32x4*)(cum + kb + 32 + 8 * g);
#pragma unroll
                for (int e = 0; e < 4; ++e) { const int kv = kb + 8 * g + e;
                    p0[4 * g + e] = (kv > qpos) ? -INFINITY : p0[4 * g + e] + (cq - c0[e]);
                    p1[4 * g + e] = (kv + 32 > qpos) ? -INFINITY : p1[4 * g + e] + (cq - c1[e]); } }
        } else {
            if (t > (qpos >> 6)) {
#pragma unroll
                for (int r = 0; r < 16; ++r) { p0[r] = -INFINITY; p1[r] = -INFINITY; } }
        }
        const float rm = rowmax(p0, p1), m_new = fmaxf(m_run, rm), alpha = __builtin_amdgcn_exp2f(m_run - m_new);
        float sum = 0.f;
#pragma unroll
        for (int r = 0; r < 16; ++r) { p0[r] = __builtin_amdgcn_exp2f(p0[r] - m_new); p1[r] = __builtin_amdgcn_exp2f(p1[r] - m_new); sum += p0[r] + p1[r]; }
        l_run = l_run * alpha + sum; m_run = m_new;
        if (hi == 0) wsf[r32] = alpha;
        asm volatile("s_waitcnt lgkmcnt(0)" ::: "memory");
#pragma unroll
        for (int d = 0; d < 2; ++d)
#pragma unroll
            for (int r = 0; r < 16; ++r) o[d][r] *= wsf[crow(r, hi)];
        asm volatile("s_waitcnt lgkmcnt(0)" ::: "memory");
        u32x4 pw0, pw1, pw2, pw3;
        pw0 = (u32x4){cvtpk_s(p0[0], p0[1]), cvtpk_s(p0[2], p0[3]), cvtpk_s(p0[4], p0[5]), cvtpk_s(p0[6], p0[7])};
        pw1 = (u32x4){cvtpk_s(p0[8], p0[9]), cvtpk_s(p0[10], p0[11]), cvtpk_s(p0[12], p0[13]), cvtpk_s(p0[14], p0[15])};
        pw2 = (u32x4){cvtpk_s(p1[0], p1[1]), cvtpk_s(p1[2], p1[3]), cvtpk_s(p1[4], p1[5]), cvtpk_s(p1[6], p1[7])};
        pw3 = (u32x4){cvtpk_s(p1[8], p1[9]), cvtpk_s(p1[10], p1[11]), cvtpk_s(p1[12], p1[13]), cvtpk_s(p1[14], p1[15])};
        ATT_SBAR();
        pv(o, vb0, __builtin_bit_cast(bf16x8, pw0), __builtin_bit_cast(bf16x8, pw1), __builtin_bit_cast(bf16x8, pw2), __builtin_bit_cast(bf16x8, pw3));
    }
    { auto rr = __builtin_amdgcn_permlane32_swap(__float_as_uint(l_run), __float_as_uint(l_run), false, false); l_run = __uint_as_float(rr[0]) + __uint_as_float(rr[1]); }
    if (hi == 0) wsf[32 + r32] = l_run;
    asm volatile("s_waitcnt lgkmcnt(0)" ::: "memory");
    LAS3 float* stg = (LAS3 float*)(lds + LDS_OST + wid * 8192);
#pragma unroll
    for (int r = 0; r < 16; ++r) { const int orow = crow(r, hi); const float rl = __builtin_amdgcn_rcpf(wsf[32 + orow]);
#pragma unroll
        for (int d0 = 0; d0 < 2; ++d0) stg[orow * 64 + d0 * 32 + r32] = o[d0][r] * rl; }
    asm volatile("s_waitcnt lgkmcnt(0)" ::: "memory");
#pragma unroll
    for (int i = 0; i < 4; ++i) { const int row = i * 8 + (lane >> 3), ch = lane & 7;
        const f32x4 a0 = *(LAS3 const f32x4*)(stg + row * 64 + ch * 8), a1 = *(LAS3 const f32x4*)(stg + row * 64 + ch * 8 + 4);
        const size_t gi = (rowbase + q0 + wid * QBLK + row) * 512 + h * 64 + ch * 8;
        const u32x4 g = *(const u32x4*)(T.G + gi);
        u32x4 w; w.x = cvtpk_s(a0[0] * bf_lo(g.x), a0[1] * bf_hi(g.x)); w.y = cvtpk_s(a0[2] * bf_lo(g.y), a0[3] * bf_hi(g.y));
        w.z = cvtpk_s(a1[0] * bf_lo(g.z), a1[1] * bf_hi(g.z)); w.w = cvtpk_s(a1[2] * bf_lo(g.w), a1[3] * bf_hi(g.w));
        *(u32x4*)(T.Y + (rowbase + q0 + wid * QBLK + row) * (size_t)T.ypitch + h * 64 + ch * 8) = w; }
    asm volatile("s_waitcnt lgkmcnt(0)" ::: "memory");
}
#undef ATT_SBAR
}

namespace attp {
#define LAS3 __attribute__((address_space(3)))
using bf16x8 = __attribute__((ext_vector_type(8))) short;
using s16x4 = __attribute__((ext_vector_type(4))) short;
using f32x16 = __attribute__((ext_vector_type(16))) float;
using f32x4 = __attribute__((ext_vector_type(4))) float;
using u32x4 = __attribute__((ext_vector_type(4))) unsigned;
constexpr int NW = 8, QBLK = 32, QB = 256, KVBLK = 64;
constexpr int KSLOTB = 12288, VSLOTB = 8192, NSLOT = 3;
constexpr int LDS_K = 0, LDS_V = NSLOT * KSLOTB, LDS_WS = LDS_V + NSLOT * VSLOTB, LDS_CUM = LDS_WS + NW * 256  , LDS_TMP = LDS_CUM + 16384, LDS_OST = LDS_TMP + 1024, LDS_BYTES = LDS_OST + NW * 4096;
__device__ __forceinline__ int crow(int r, int hi) { return (r & 3) + 8 * (r >> 2) + 4 * hi; }
typedef float f32x2_t __attribute__((ext_vector_type(2))); typedef __bf16 bf16x2_t __attribute__((ext_vector_type(2)));
__device__ __forceinline__ unsigned cvtpk_s(float lo, float hi) { f32x2_t v = {lo, hi}; bf16x2_t b = __builtin_convertvector(v, bf16x2_t); return __builtin_bit_cast(unsigned, b); }
__device__ __forceinline__ float bf_lo(unsigned u) { return __uint_as_float(u << 16); }
__device__ __forceinline__ float bf_hi(unsigned u) { return __uint_as_float(u & 0xffff0000u); }
__device__ __forceinline__ void glds16(const void* gsrc, unsigned lds_dst) { unsigned keep;
    asm volatile("s_mov_b32 %0, m0\n\ts_mov_b32 m0, %2\n\ts_nop 0\n\tglobal_load_lds_dwordx4 %1, off\n\ts_mov_b32 m0, %0" : "=&s"(keep) : "v"(gsrc), "s"(lds_dst) : "memory"); }
typedef LAS3 const char* lds_cptr;
typedef short v4i16_t __attribute__((ext_vector_type(4)));
typedef int v4i32_t __attribute__((ext_vector_type(4)));
__device__ __forceinline__ void kload2(bf16x8* kf, lds_cptr kp, int j) { kf[2 * j] = *(LAS3 const bf16x8*)(kp + j * 2048); kf[2 * j + 1] = *(LAS3 const bf16x8*)(kp + j * 2048 + 512); }
__device__ __forceinline__ s16x4 vtr(lds_cptr p) { return __builtin_bit_cast(s16x4, __builtin_amdgcn_ds_read_tr16_b64_v4i16((LAS3 v4i16_t*)p)); }
#define AP_SBAR() __builtin_amdgcn_sched_barrier(0)
#define AP_WAIT_BAR(N) asm volatile("s_waitcnt vmcnt(" #N ") lgkmcnt(0)\n\ts_barrier" ::: "memory")
#define AP_MX3(a, b, c) __builtin_fmaxf(__builtin_fmaxf((a), (b)), (c))
__device__ __forceinline__ float rowmax(const f32x16& p0, const f32x16& p1) {
    float a = AP_MX3(p0[0], p0[1], p1[0]), b = AP_MX3(p0[2], p0[3], p1[1]); a = AP_MX3(a, p1[2], p1[3]);
#pragma unroll
    for (int r = 4; r < 16; r += 4) { a = AP_MX3(a, p0[r], p0[r + 1]); b = AP_MX3(b, p0[r + 2], p0[r + 3]); a = AP_MX3(a, p1[r], p1[r + 1]); b = AP_MX3(b, p1[r + 2], p1[r + 3]); }
    float m = __builtin_fmaxf(a, b); auto rr = __builtin_amdgcn_permlane32_swap(__float_as_uint(m), __float_as_uint(m), false, false);
    return __builtin_fmaxf(__uint_as_float(rr[0]), __uint_as_float(rr[1]));
}
__device__ __forceinline__ void pv(f32x16* o, int vb, bf16x8 pa0, bf16x8 pa1, bf16x8 pa2, bf16x8 pa3) {
#pragma unroll
    for (int d0 = 0; d0 < 2; ++d0) { s16x4 lo[4], hi[4];
#pragma unroll
        for (int ks = 0; ks < 4; ++ks) {
            asm volatile("ds_read_b64_tr_b16 %0,%1 offset:%c2" : "=&v"(lo[ks]) : "v"(vb), "i"(d0 * 4096 + ks * 1024) : "memory");
            asm volatile("ds_read_b64_tr_b16 %0,%1 offset:%c2" : "=&v"(hi[ks]) : "v"(vb), "i"(d0 * 4096 + ks * 1024 + 512) : "memory"); }
        asm volatile("s_waitcnt lgkmcnt(0)" ::: "memory"); AP_SBAR();
#define AP_PK(k) (bf16x8){lo[k][0], lo[k][1], lo[k][2], lo[k][3], hi[k][0], hi[k][1], hi[k][2], hi[k][3]}
        o[d0] = __builtin_amdgcn_mfma_f32_32x32x16_bf16(pa0, AP_PK(0), o[d0], 0, 0, 0);
        o[d0] = __builtin_amdgcn_mfma_f32_32x32x16_bf16(pa1, AP_PK(1), o[d0], 0, 0, 0);
        o[d0] = __builtin_amdgcn_mfma_f32_32x32x16_bf16(pa2, AP_PK(2), o[d0], 0, 0, 0);
        o[d0] = __builtin_amdgcn_mfma_f32_32x32x16_bf16(pa3, AP_PK(3), o[d0], 0, 0, 0);
#undef AP_PK
    }
}
struct Tensors {
    const unsigned short *Q1, *Q2, *K1, *K2, *V, *G; unsigned short* Y; int ypitch;
};
__device__ __forceinline__ void cmask(f32x16& p0, f32x16& p1, int jb, int qrel, int hi) {
    int d = qrel - (64 * jb + 4 * hi); asm volatile("" : "+v"(d));
#pragma unroll
    for (int r = 0; r < 16; ++r) { const int c = (r & 3) + 8 * (r >> 2); if (c > d) p0[r] = -INFINITY; if (c + 32 > d) p1[r] = -INFINITY; }
}
__device__ __forceinline__ void chmask(f32x16& p0, f32x16& p1, int jb, int wchunk) {
    if (jb > wchunk) {
#pragma unroll
        for (int r = 0; r < 16; ++r) { p0[r] = -INFINITY; p1[r] = -INFINITY; } }
}

__device__ __forceinline__ int fox_t0(LAS3 const float* cum, int q0, int ntf, float thr) {
    const int lane = pg8::lane_id_asm();
    const float c0 = cum[q0], ck = cum[(lane < ntf ? lane : ntf - 1) * KVBLK + KVBLK - 1];
    const bool need = (lane < ntf) && !(c0 - ck < -thr);
    const unsigned long long m = __ballot(need);
    int t = m ? (int)__builtin_ctzll(m) : 0;
    t &= ~1; if (t > ntf - 4) t = ntf - 4; if (t < 0) t = 0;
    return __builtin_amdgcn_readfirstlane(t);
}
template <int MODE, int THRL, bool FIXREF, bool EARLY> __device__ __forceinline__ int attn_unit(int b, int h, int qb, const Tensors& T, LAS3 unsigned char* lds, int wid  , float bnd,
                                                                                 int s0, bool pre, int nmode, const unsigned char* wsn, int bn, int hn, int qbn, bf16x8 (&qx)[6], int t0, int t0n, int cumsel) {
    constexpr int NQ = MODE ? 6 : 4, NKF = 2 * NQ;
    const int lane = pg8::lane_id_asm(), r32 = lane & 31, hi = lane >> 5;
    const size_t rowbase = (size_t)b * SEQ; const int q0 = qb * QB;
    const unsigned lds0 = (unsigned)(uintptr_t)lds;
    LAS3 float* wsf = (LAS3 float*)(lds + LDS_WS) + wid * 64;
    LAS3 const float* cum = (LAS3 const float*)(lds + LDS_CUM + cumsel * 8192);
    const unsigned short* ksrc = T.K1 + (rowbase + (size_t)t0 * KVBLK + lane) * 512 + h * 64 + wid * 8;
    const unsigned short* k2src = MODE ? T.K2 + (rowbase + (size_t)t0 * KVBLK + lane) * 32 + (wid & 3) * 8 : nullptr;
    const unsigned short* vsrc = T.V + (rowbase + (size_t)t0 * KVBLK + 16 * (wid & 3) + (lane >> 2)) * 512 + h * 64 + (wid >> 2) * 32 + (lane & 3) * 8;
    const unsigned kdst = lds0 + LDS_K + wid * 1024, k2dst = lds0 + LDS_K + (8 + (wid & 3)) * 1024, vdst = lds0 + LDS_V + wid * 1024;
#define DMA_K(t, si) do { glds16(ksrc + (size_t)(t) * KVBLK * 512, (unsigned)__builtin_amdgcn_readfirstlane(kdst + (si) * KSLOTB)); \
        if (MODE) glds16(k2src + (size_t)(t) * KVBLK * 32, (unsigned)__builtin_amdgcn_readfirstlane(k2dst + (si) * KSLOTB)); } while (0)
#define DMA_V(t, si) glds16(vsrc + (size_t)(t) * KVBLK * 512, (unsigned)__builtin_amdgcn_readfirstlane(vdst + (si) * VSLOTB))
    const int vb0 = (int)(lds0 + LDS_V) + ((lane >> 4) & 1) * 32 + (lane & 3) * 8 + (4 * hi + ((lane & 15) >> 2)) * 64;
    const lds_cptr lds3 = (lds_cptr)lds; const lds_cptr kp0 = lds3 + LDS_K + hi * 1024 + r32 * 16;
    const lds_cptr vp0 = lds3 + LDS_V + ((lane >> 4) & 1) * 32 + (lane & 3) * 8 + (4 * hi + ((lane & 15) >> 2)) * 64;
    bf16x8 kf[NKF];
    const int NT = (q0 + QB) / KVBLK - t0;
    LAS3 const float* cumt = cum + t0 * KVBLK;
    const int NTc = NT - (EARLY ? 2 : 0);
    const int s1 = (s0 == NSLOT - 1) ? 0 : s0 + 1, s2 = (s1 == NSLOT - 1) ? 0 : s1 + 1;
    if (!pre) { DMA_K(0, s0); DMA_V(0, s0); DMA_K(1, s1); }
    bf16x8 qr[NQ];
    constexpr bool QPF = FIXREF;
    if (pre && QPF) {
#pragma unroll
        for (int d0 = 0; d0 < NQ; ++d0) qr[d0] = qx[d0];
    } else { const size_t qrow = rowbase + q0 + wid * QBLK + r32;
#pragma unroll
      for (int d0 = 0; d0 < 4; ++d0) qr[d0] = *(const bf16x8*)(T.Q1 + qrow * 512 + h * 64 + d0 * 16 + hi * 8);
      if (MODE) {
#pragma unroll
          for (int d0 = 0; d0 < 2; ++d0) qr[4 + d0] = *(const bf16x8*)(T.Q2 + qrow * 256 + h * 32 + d0 * 16 + hi * 8); }
      if (QPF) { asm volatile("s_waitcnt vmcnt(0)" ::: "memory");
#pragma unroll
          for (int d0 = 0; d0 < NQ; ++d0) asm volatile("" : "+v"(qr[d0])); } }
    static_assert(FIXREF, "the row sums ride on the MFMA pipe (ones operand): only the reference-free units are instantiated");
    float mhat = 0.f; f32x16 o[2], lacc;
    bf16x8 ones; { int w_ = 0x3F803F80; asm volatile("" : "+v"(w_)); const v4i32_t t_ = {w_, w_, w_, w_}; ones = __builtin_bit_cast(bf16x8, t_); }
    { float z_ = 0.f; asm volatile("" : "+v"(z_));
#pragma unroll
      for (int r = 0; r < 16; ++r) lacc[r] = z_; }
    { float z_ = 0.f; asm volatile("" : "+v"(z_));
#pragma unroll
      for (int r = 0; r < 16; ++r) { o[0][r] = z_; o[1][r] = z_; } }
    const int qrel = wid * QBLK + r32, wchunk = wid >> 1;
    const float cq = MODE ? 0.f : cum[q0 + qrel];
    float base = cq;
    (void)bnd;
    bool resc = false;
#define CMASK(P0, P1, t) do { int jb_ = (t) - (NT - 4); if (MODE ? (jb_ >= 0) : (jb_ >= wchunk)) {        if (MODE) chmask(P0, P1, jb_, wchunk); else cmask(P0, P1, jb_, qrel, hi); } } while (0)
#define PREFILL4(X0, X1, tt, G) do { if (MODE) { if ((G) < 4) { X0[4 * (G)] = base; X0[4 * (G) + 1] = base; X0[4 * (G) + 2] = base; X0[4 * (G) + 3] = base; } \
                                               else { X1[4 * ((G) - 4)] = base; X1[4 * ((G) - 4) + 1] = base; X1[4 * ((G) - 4) + 2] = base; X1[4 * ((G) - 4) + 3] = base; } } \
        else { const f32x4 c_ = *(LAS3 const f32x4*)(cumt + (tt) * KVBLK + 4 * hi + 8 * ((G) & 3) + 32 * ((G) >> 2)); \
               if ((G) < 4) { X0[4 * (G)] = base - c_[0]; X0[4 * (G) + 1] = base - c_[1]; X0[4 * (G) + 2] = base - c_[2]; X0[4 * (G) + 3] = base - c_[3]; } \
               else { X1[4 * ((G) - 4)] = base - c_[0]; X1[4 * ((G) - 4) + 1] = base - c_[1]; X1[4 * ((G) - 4) + 2] = base - c_[2]; X1[4 * ((G) - 4) + 3] = base - c_[3]; } } } while (0)
#define CRD(cv, tt, G) do { cv = *(LAS3 const f32x4*)(cumt + (tt) * KVBLK + 4 * hi + 8 * ((G) & 3) + 32 * ((G) >> 2)); } while (0)
#define FSUB(d, a, b) do { asm("v_sub_f32 %0, %1, %2" : "=v"(d) : "v"(a), "v"(b)); } while (0)
#define PREFILL4U(X0, X1, cv, G) do { if ((G) < 4) { FSUB(X0[4 * (G)], base, cv[0]); FSUB(X0[4 * (G) + 1], base, cv[1]); FSUB(X0[4 * (G) + 2], base, cv[2]); FSUB(X0[4 * (G) + 3], base, cv[3]); } \
               else { FSUB(X1[4 * ((G) - 4)], base, cv[0]); FSUB(X1[4 * ((G) - 4) + 1], base, cv[1]); FSUB(X1[4 * ((G) - 4) + 2], base, cv[2]); FSUB(X1[4 * ((G) - 4) + 3], base, cv[3]); } } while (0)
#define PREFILL_ALL(X0, X1, tt) do { PREFILL4(X0, X1, tt, 0); PREFILL4(X0, X1, tt, 1); PREFILL4(X0, X1, tt, 2); PREFILL4(X0, X1, tt, 3); PREFILL4(X0, X1, tt, 4); PREFILL4(X0, X1, tt, 5); PREFILL4(X0, X1, tt, 6); PREFILL4(X0, X1, tt, 7); \
        asm volatile("" : "+v"(X0), "+v"(X1)); } while (0)
#define RESC() do { if (resc) { asm volatile("s_waitcnt lgkmcnt(0)" ::: "memory"); \
      _Pragma("unroll") for (int d_ = 0; d_ < 2; ++d_) _Pragma("unroll") for (int r = 0; r < 16; ++r) o[d_][r] *= wsf[crow(r, hi)]; } } while (0)
    f32x16 pA0, pA1, pB0, pB1;
    int si_prev = s0, si_cur = s0, si_next = s1;
#define ROT() do { si_prev = si_cur; si_cur = si_next; si_next = (si_next == NSLOT - 1) ? 0 : si_next + 1; } while (0)
    if (!pre) DMA_K(2, s2);
    if (!MODE) PREFILL_ALL(pA0, pA1, 0);
    if (pre && QPF) AP_WAIT_BAR(4);
    else if (MODE) AP_WAIT_BAR(5); else AP_WAIT_BAR(3);
    {
#pragma unroll
        for (int j = 0; j < NQ; ++j) kload2(kf, kp0 + s0 * KSLOTB, j);
#pragma unroll
        for (int d0 = 0; d0 < NQ; ++d0) { if (MODE && d0 == 0) { float z_ = 0.f; asm volatile("" : "+v"(z_)); _Pragma("unroll") for (int r = 0; r < 16; ++r) { pA0[r] = z_; pA1[r] = z_; } }
            pA0 = __builtin_amdgcn_mfma_f32_32x32x16_bf16(kf[2 * d0], qr[d0], pA0, 0, 0, 0); pA1 = __builtin_amdgcn_mfma_f32_32x32x16_bf16(kf[2 * d0 + 1], qr[d0], pA1, 0, 0, 0); }
        CMASK(pA0, pA1, 0);
        if (FIXREF) {
#pragma unroll
            for (int r = 0; r < 16; ++r) pA0[r] = __builtin_amdgcn_exp2f(pA0[r]);
        } else {
        const float rm = rowmax(pA0, pA1); mhat = rm; base = cq - mhat;
#pragma unroll
        for (int r = 0; r < 16; ++r) { pA0[r] = __builtin_amdgcn_exp2f(pA0[r] - rm); pA1[r] = __builtin_amdgcn_exp2f(pA1[r] - rm); } }
    }
    if (!MODE) PREFILL_ALL(pB0, pB1, 1);
    if (pre && QPF) AP_WAIT_BAR(4); else AP_WAIT_BAR(0);
    DMA_K(3, s0); DMA_V(1, s1);
    ROT();
#pragma unroll
    for (int j = 0; j < NQ; ++j) kload2(kf, kp0 + si_cur * KSLOTB, j);
    if (MODE) AP_WAIT_BAR(3); else AP_WAIT_BAR(2);
    s16x4 vlo[8], vhi[8]; u32x4 pw0, pw1, pw2, pw3;
#define PKW(P, B) cvtpk_s(P[B], P[B + 1])
#define PAF(k) __builtin_bit_cast(bf16x8, pw##k)
#define VFR(i) (bf16x8){vlo[i][0], vlo[i][1], vlo[i][2], vlo[i][3], vhi[i][0], vhi[i][1], vhi[i][2], vhi[i][3]}
#define PIN(x) asm volatile("" : "+v"(x))
#define FADD(a, b) do { asm("v_add_f32 %0, %0, %1" : "+v"(a) : "v"(b)); } while (0)
#define GAPA(MF, EXV, EXB, W0, W1, PW) do { MF; if ((EXB) >= 0) { EXV[(EXB) & 15] = EX(EXV[(EXB) & 15]); EXV[((EXB) + 1) & 15] = EX(EXV[((EXB) + 1) & 15]); EXV[((EXB) + 2) & 15] = EX(EXV[((EXB) + 2) & 15]); EXV[((EXB) + 3) & 15] = EX(EXV[((EXB) + 3) & 15]); PIN(EXV); } W0; W1; PIN(PW); AP_SBAR(); } while (0)
#define LMF(k) do { lacc = __builtin_amdgcn_mfma_f32_32x32x16_bf16(PAF(k), ones, lacc, 0, 0, 0); } while (0)
#define EX(v) __builtin_amdgcn_exp2f((MODE && !FIXREF) ? (v) + base : (v))
#define GAPB(MF, X, B, GP, Y0, Y1, tt, G, CUR, NXT) do { MF; X[B] = EX(X[B]); X[B + 1] = EX(X[B + 1]); PIN(X);        if ((GP) && !MODE) { PREFILL4U(Y0, Y1, ca_, G); if ((G) < 4) PIN(Y0); else PIN(Y1); if ((G) < 7) CRD(ca_, tt, (G) + 1); } AP_SBAR(); } while (0)
#define VRD(i) do { vlo[i] = vtr(vp_ + (((i) >> 2) * 4096 + ((i) & 3) * 1024)); vhi[i] = vtr(vp_ + (((i) >> 2) * 4096 + ((i) & 3) * 1024 + 512)); } while (0)
#define KRD(Gf, j) do { if (Gf) { kload2(kf, kp0 + si_next * KSLOTB, j); AP_SBAR(); } } while (0)
#define MF(Cx, kidx, qidx) Cx = __builtin_amdgcn_mfma_f32_32x32x16_bf16(kf[kidx], qr[qidx], Cx, 0, 0, 0)
#define MF0(Cx, kidx, qidx) do { if (MODE) Cx = __builtin_amdgcn_mfma_f32_32x32x16_bf16(kf[kidx], qr[qidx], (f32x16){0.f, 0.f, 0.f, 0.f, 0.f, 0.f, 0.f, 0.f, 0.f, 0.f, 0.f, 0.f, 0.f, 0.f, 0.f, 0.f}, 0, 0, 0); else MF(Cx, kidx, qidx); } while (0)
#define STEP(C0, C1, P0, P1, t, GK, GV, GL, GP, QN) do { AP_SBAR(); \
    const lds_cptr vp_ = vp0 + si_prev * VSLOTB; \
    VRD(0); AP_SBAR(); \
    GAPA(MF0(C0, 0, 0), P1, 0,  pw0[0] = PKW(P0, 0), pw0[1] = PKW(P0, 2), pw0); \
    VRD(4); AP_SBAR(); GAPA(MF0(C1, 1, 0), P1, 4,  pw0[2] = PKW(P0, 4), pw0[3] = PKW(P0, 6), pw0); \
    VRD(1); AP_SBAR(); GAPA(MF(C0, 2, 1),   P1, 8,  pw1[0] = PKW(P0, 8), pw1[1] = PKW(P0, 10), pw1); \
    VRD(5); AP_SBAR(); GAPA(MF(C1, 3, 1),   P1, 12, pw1[2] = PKW(P0, 12), pw1[3] = PKW(P0, 14), pw1); \
    VRD(2); AP_SBAR(); GAPA(MF(C0, 4, 2),   P1, -1, pw2[0] = PKW(P1, 0), pw2[1] = PKW(P1, 2), pw2); \
    VRD(6); AP_SBAR(); GAPA(MF(C1, 5, 2),   P1, -1, pw2[2] = PKW(P1, 4), pw2[3] = PKW(P1, 6), pw2); \
    VRD(3); AP_SBAR(); GAPA(MF(C0, 6, 3),   P1, -1, pw3[0] = PKW(P1, 8), pw3[1] = PKW(P1, 10), pw3); \
    VRD(7); AP_SBAR(); GAPA(MF(C1, 7, 3),   P1, -1, pw3[2] = PKW(P1, 12), pw3[3] = PKW(P1, 14), pw3); \
    if (MODE) { MF(C0, 8, 4); MF(C1, 9, 4); MF(C0, 10, 5); MF(C1, 11, 5); AP_SBAR(); } \
    f32x4 ca_; if ((GP) && !MODE) CRD(ca_, (t) + 1, 0); \
    if (GK) { DMA_K((t) + 3, si_cur); } if (GV) { DMA_V((t) + 1, si_next); } \
    CMASK(C0, C1, t); \
    if (!FIXREF) { float a = AP_MX3(C0[0], C0[1], C1[0]), b_ = AP_MX3(C0[2], C0[3], C1[1]); a = AP_MX3(a, C1[2], C1[3]); \
      _Pragma("unroll") for (int r = 4; r < 16; r += 4) { a = AP_MX3(a, C0[r], C0[r + 1]); b_ = AP_MX3(b_, C0[r + 2], C0[r + 3]); a = AP_MX3(a, C1[r], C1[r + 1]); b_ = AP_MX3(b_, C1[r + 2], C1[r + 3]); } \
      float rm = __builtin_fmaxf(a, b_); { auto rr = __builtin_amdgcn_permlane32_swap(__float_as_uint(rm), __float_as_uint(rm), false, false); rm = __builtin_fmaxf(__uint_as_float(rr[0]), __uint_as_float(rr[1])); } \
      resc = false; if (MODE) rm += base; \
      if (__builtin_expect(__any(rm > (float)THRL), 0)) { const float dl = __builtin_fmaxf(rm, 0.f); mhat += dl; base = cq - mhat; \
        if (!MODE) { _Pragma("unroll") for (int r = 0; r < 16; ++r) { C0[r] -= dl; C1[r] -= dl; } } \
        const float f = __builtin_amdgcn_exp2f(-dl); if (hi == 0) wsf[r32] = f; resc = true; } } \
    AP_SBAR(); if (QN) { QNLOAD(); AP_SBAR(); }        \
    GAPB(o[0] = __builtin_amdgcn_mfma_f32_32x32x16_bf16(PAF(0), VFR(0), o[0], 0, 0, 0); LMF(0), C0, 0, GP, P0, P1, (t) + 1, 0, ca_, cb_); \
    if (MODE) KRD(GL, 0); \
    GAPB(o[1] = __builtin_amdgcn_mfma_f32_32x32x16_bf16(PAF(0), VFR(4), o[1], 0, 0, 0), C0, 2, GP, P0, P1, (t) + 1, 1, cb_, ca_); \
    KRD(GL, MODE ? 1 : 0); GAPB(o[0] = __builtin_amdgcn_mfma_f32_32x32x16_bf16(PAF(1), VFR(1), o[0], 0, 0, 0); LMF(1), C0, 4, GP, P0, P1, (t) + 1, 2, ca_, cb_); \
    KRD(GL, MODE ? 2 : 1); GAPB(o[1] = __builtin_amdgcn_mfma_f32_32x32x16_bf16(PAF(1), VFR(5), o[1], 0, 0, 0), C0, 6, GP, P0, P1, (t) + 1, 3, cb_, ca_); \
    KRD(GL, MODE ? 3 : 2); GAPB(o[0] = __builtin_amdgcn_mfma_f32_32x32x16_bf16(PAF(2), VFR(2), o[0], 0, 0, 0); LMF(2), C0, 8, GP, P0, P1, (t) + 1, 4, ca_, cb_); \
    KRD(GL, MODE ? 4 : 3); GAPB(o[1] = __builtin_amdgcn_mfma_f32_32x32x16_bf16(PAF(2), VFR(6), o[1], 0, 0, 0), C0, 10, GP, P0, P1, (t) + 1, 5, cb_, ca_); \
    if (MODE) KRD(GL, 5); \
    GAPB(o[0] = __builtin_amdgcn_mfma_f32_32x32x16_bf16(PAF(3), VFR(3), o[0], 0, 0, 0); LMF(3), C0, 12, GP, P0, P1, (t) + 1, 6, ca_, cb_); \
    GAPB(o[1] = __builtin_amdgcn_mfma_f32_32x32x16_bf16(PAF(3), VFR(7), o[1], 0, 0, 0), C0, 14, GP, P0, P1, (t) + 1, 7, cb_, ca_); \
    } while (0)
#define STEADY_WAIT() do { if (MODE) AP_WAIT_BAR(3); else AP_WAIT_BAR(2); } while (0)
    u32x4 gq[4];
#define QNLOAD() do { const int ln_ = pg8::lane_id_asm(); \
        _Pragma("unroll") for (int d0 = 0; d0 < 6; ++d0) asm volatile("" : "=v"(qx[d0]));        \
        if (nmode >= 0) { const size_t qrow_ = (size_t)bn * SEQ + qbn * QB + wid * QBLK + (ln_ & 31); \
            const unsigned short* q1_ = (const unsigned short*)(wsn + (nmode ? WSO_QAN : WSO_QB)) + qrow_ * 512 + hn * 64 + (ln_ >> 5) * 8; \
            _Pragma("unroll") for (int d0 = 0; d0 < 4; ++d0) qx[d0] = *(const bf16x8*)(q1_ + d0 * 16); \
            if (nmode) { const unsigned short* q2_ = (const unsigned short*)(wsn + WSO_QAR) + qrow_ * 256 + hn * 32 + (ln_ >> 5) * 8; \
                _Pragma("unroll") for (int d0 = 0; d0 < 2; ++d0) qx[4 + d0] = *(const bf16x8*)(q2_ + d0 * 16); } } \
        _Pragma("unroll") for (int i = 0; i < 4; ++i) gq[i] = *(const u32x4*)(T.G + (rowbase + q0 + wid * QBLK + i * 8 + (ln_ >> 3)) * 512 + h * 64 + (ln_ & 7) * 8); } while (0)
    int t = 1;
#undef CMASK
#define CMASK(P0, P1, t) do { } while (0)
    for (; t + 5 < NTc; t += 2) {
        STEP(pB0, pB1, pA0, pA1, t, true, true, true, true, false);       STEADY_WAIT(); RESC(); ROT();
        STEP(pA0, pA1, pB0, pB1, t + 1, true, true, true, true, false);   STEADY_WAIT(); RESC(); ROT();
    }
#undef CMASK
#define CMASK(P0, P1, t) do { int jb_ = (t) - (NT - 4); if (MODE ? (jb_ >= 0) : (jb_ >= wchunk)) {        if (MODE) chmask(P0, P1, jb_, wchunk); else cmask(P0, P1, jb_, qrel, hi); } } while (0)
#define ENDW(tt) do { if ((tt) + 3 < NT) { STEADY_WAIT(); } else if ((tt) + 2 < NT) { AP_WAIT_BAR(1); } else { AP_WAIT_BAR(0); } } while (0)
    for (; t + 1 < NTc; t += 2) {
        STEP(pB0, pB1, pA0, pA1, t, (t + 3 < NT), (t + 1 < NT), (t + 1 < NTc), (t + 1 < NTc), false);           ENDW(t);     RESC(); ROT();
        STEP(pA0, pA1, pB0, pB1, t + 1, (t + 4 < NT), (t + 2 < NT), (t + 2 < NTc), (t + 2 < NTc), false);       ENDW(t + 1); RESC(); ROT();
    }
#define DRAIN(sl_) do { \
      _Pragma("unroll") for (int r = 0; r < 16; ++r) pB1[r] = EX(pB1[r]); \
      pw0 = (u32x4){PKW(pB0, 0), PKW(pB0, 2), PKW(pB0, 4), PKW(pB0, 6)}; pw1 = (u32x4){PKW(pB0, 8), PKW(pB0, 10), PKW(pB0, 12), PKW(pB0, 14)}; \
      pw2 = (u32x4){PKW(pB1, 0), PKW(pB1, 2), PKW(pB1, 4), PKW(pB1, 6)}; pw3 = (u32x4){PKW(pB1, 8), PKW(pB1, 10), PKW(pB1, 12), PKW(pB1, 14)}; \
      AP_SBAR(); LMF(0); LMF(1); LMF(2); LMF(3); pv(o, vb0 + (sl_) * VSLOTB, PAF(0), PAF(1), PAF(2), PAF(3)); } while (0)
    if (EARLY) {
        STEP(pB0, pB1, pA0, pA1, NTc - 1, false, true, false, false, false);
        const int sd = si_cur;
        ENDW(NTc - 1); ROT();
        DMA_V(NT - 1, si_next);
        if ((wid >> 1) == 1) DRAIN(sd);
        ENDW(NT - 2); ROT();
    }
    int sret = 0;
    if (nmode >= 0) {
        const int n0 = si_next, n1 = (n0 == NSLOT - 1) ? 0 : n0 + 1, n2 = (n1 == NSLOT - 1) ? 0 : n1 + 1; sret = n0;
        const size_t nrow = (size_t)bn * SEQ + (size_t)t0n * KVBLK; const int ln_ = pg8::lane_id_asm();
        const unsigned short* nk = (const unsigned short*)(wsn + (nmode ? WSO_KAN : WSO_KB)) + (nrow + ln_) * 512 + hn * 64 + wid * 8;
        const unsigned short* nk2 = (const unsigned short*)(wsn + WSO_KROPE) + (nrow + ln_) * 32 + (wid & 3) * 8;
        const unsigned short* nv = (const unsigned short*)(wsn + (nmode ? WSO_VA : WSO_VB)) + (nrow + 16 * (wid & 3) + (ln_ >> 2)) * 512 + hn * 64 + (wid >> 2) * 32 + (ln_ & 3) * 8;
#define NDMA_K(t, si) do { glds16(nk + (size_t)(t) * KVBLK * 512, (unsigned)__builtin_amdgcn_readfirstlane(kdst + (si) * KSLOTB)); \
        if (nmode) glds16(nk2 + (size_t)(t) * KVBLK * 32, (unsigned)__builtin_amdgcn_readfirstlane(k2dst + (si) * KSLOTB)); } while (0)
        NDMA_K(0, n0); glds16(nv, (unsigned)__builtin_amdgcn_readfirstlane(vdst + n0 * VSLOTB)); NDMA_K(1, n1); NDMA_K(2, n2);
#undef NDMA_K
    }
    if (EARLY) { QNLOAD(); }
    else { STEP(pB0, pB1, pA0, pA1, NT - 1, false, false, false, false, QPF); RESC(); }
#undef QNLOAD
    if (!QPF) {
#pragma unroll
        for (int i = 0; i < 4; ++i) gq[i] = *(const u32x4*)(T.G + (rowbase + q0 + wid * QBLK + i * 8 + (lane >> 3)) * 512 + h * 64 + (lane & 7) * 8); }
    if (!EARLY) { if ((wid >> 1) == 3) DRAIN(si_cur); }
#undef DRAIN
    { LAS3 unsigned short* stg = (LAS3 unsigned short*)(lds + LDS_OST) + wid * 2048;
#pragma unroll
      for (int r = 0; r < 16; r += 1) { const int orow = crow(r, hi); const float rl = __builtin_amdgcn_rcpf(lacc[r]);
#pragma unroll
          for (int d0 = 0; d0 < 2; ++d0) stg[orow * 64 + d0 * 32 + r32] = (unsigned short)(cvtpk_s(o[d0][r] * rl, 0.f) & 0xffffu); }
      asm volatile("s_waitcnt lgkmcnt(0)" ::: "memory");
      if (QPF) {
#pragma unroll
          for (int d0 = 0; d0 < 6; ++d0) asm volatile("" : "+v"(qx[d0])); }
#pragma unroll
      for (int i = 0; i < 4; ++i) { const int row = i * 8 + (lane >> 3), ch = lane & 7; const u32x4 v = *(LAS3 const u32x4*)(stg + row * 64 + ch * 8);
          const u32x4 g = gq[i];
          u32x4 w; w.x = cvtpk_s(bf_lo(v.x) * bf_lo(g.x), bf_hi(v.x) * bf_hi(g.x)); w.y = cvtpk_s(bf_lo(v.y) * bf_lo(g.y), bf_hi(v.y) * bf_hi(g.y));
          w.z = cvtpk_s(bf_lo(v.z) * bf_lo(g.z), bf_hi(v.z) * bf_hi(g.z)); w.w = cvtpk_s(bf_lo(v.w) * bf_lo(g.w), bf_hi(v.w) * bf_hi(g.w));
          __builtin_nontemporal_store(w, (u32x4*)(T.Y + (rowbase + q0 + wid * QBLK + row) * (size_t)T.ypitch + h * 64 + ch * 8)); } }
    if (!QPF) {
#pragma unroll
        for (int d0 = 0; d0 < 6; ++d0) asm volatile("" : "=v"(qx[d0])); }
    asm volatile("s_waitcnt lgkmcnt(0)\n\ts_barrier" ::: "memory");
    return sret;
#undef DMA_K
#undef DMA_V
#undef CMASK
#undef PREFILL4
#undef PREFILL4U
#undef CRD
#undef PREFILL_ALL
#undef RESC
#undef ROT
#undef PKW
#undef PAF
#undef VFR
#undef PIN
#undef GAPA
#undef LMF
#undef FADD
#undef FSUB
#undef GAPB
#undef EX
#undef VRD
#undef KRD
#undef MF
#undef MF0
#undef STEP
#undef STEADY_WAIT
#undef ENDW
}
#undef AP_SBAR
#undef AP_WAIT_BAR
#undef AP_MX3
}

constexpr int NWAVES = 8;
#ifndef MK_N_LAUNCHES
#define MK_N_LAUNCHES 1
#endif
constexpr int N_PHASES = 7;
constexpr int N_LAUNCHES = MK_N_LAUNCHES;
static_assert(N_LAUNCHES == 1 || N_LAUNCHES == N_PHASES, "MK_N_LAUNCHES is 1 or 7");

constexpr int CW_BAR = 4096;

constexpr int RING_OFF = 0, RING_BYTES = 131072;
constexpr int LDSCTL_OFF = RING_BYTES, MISC_OFF = LDSCTL_OFF + 320;
constexpr int LDS_BYTES = 147456;
static_assert(att::LDS_BYTES <= RING_BYTES && attp::LDS_BYTES <= RING_BYTES, "attention scratch fits the ring region");

#define GAS __attribute__((address_space(1)))
#define LAS __attribute__((address_space(3)))
typedef unsigned short bf16;
typedef unsigned v4u __attribute__((ext_vector_type(4)));
typedef float f32x4 __attribute__((ext_vector_type(4)));
typedef short bf16x8 __attribute__((ext_vector_type(8)));
typedef GAS unsigned gu32;
typedef GAS unsigned long long gu64;
#define RLX_AGENT __ATOMIC_RELAXED, __HIP_MEMORY_SCOPE_AGENT
#define LDS_WAIT() asm volatile("s_waitcnt lgkmcnt(0)" ::: "memory")
#define VM_WAIT() asm volatile("s_waitcnt vmcnt(0)" ::: "memory")
__device__ __forceinline__ unsigned long long rt() { return __builtin_amdgcn_s_memrealtime(); }
__device__ __forceinline__ unsigned f2bf(float f) { unsigned u = __builtin_bit_cast(unsigned, f); return (u + 0x7fffu + ((u >> 16) & 1u)) >> 16; }
__device__ __forceinline__ unsigned pk2(float lo, float hi) { return f2bf(lo) | (f2bf(hi) << 16); }

#define XB_TMO      128
#define XB_XCNT(j)  (256  + 64 * (j))
#define XB_XSUB(j)  (1280 + 64 * (j))
#define XB_XGEN(j)  (2304 + 64 * (j))
#define XB_TOP      3328
#define XB_TOPGEN   3392
#define XCD_BAR_WORDS 3456
#define XB_SPIN_CAP (1u << 18)

__device__ __forceinline__ unsigned xb_ld(unsigned* p)              { return __hip_atomic_load(p, __ATOMIC_RELAXED, __HIP_MEMORY_SCOPE_AGENT); }
__device__ __forceinline__ unsigned xb_add(unsigned* p, unsigned v) { return __hip_atomic_fetch_add(p, v, __ATOMIC_RELAXED, __HIP_MEMORY_SCOPE_AGENT); }
__device__ __forceinline__ unsigned xb_xcc_id() { return (unsigned)__builtin_amdgcn_s_getreg((3 << 11) | 20) & 0xFu; }
#define XB_SPIN(cond, bar) do { unsigned _sp = 0; while (cond) { __builtin_amdgcn_s_sleep(1); \
    if ((++_sp & 255u) == 0u) { if (xb_ld(&(bar)[XB_TMO])) break; if (_sp > XB_SPIN_CAP) { atomicAdd(&(bar)[XB_TMO], 1u); break; } } } } while (0)

struct XcdBarrier {
    unsigned* bar; unsigned x;
    volatile LAS unsigned* st;
};

__device__ __forceinline__ XcdBarrier xcd_barrier_post(unsigned* bar, volatile LAS unsigned* st) {
    XcdBarrier b; b.bar = bar; b.x = xb_xcc_id(); b.st = st;
    if (threadIdx.x == 0) (void)xb_add(&bar[XB_XCNT(b.x)], 1u);
    return b;
}
__device__ __forceinline__ void xcd_barrier_complete(unsigned* bar, unsigned x, unsigned& nloc, unsigned& nx) {
    const unsigned G = gridDim.x * gridDim.y * gridDim.z;
    unsigned sum, cnt, mine, sp = 0u;
    for (;;) {
        sum = 0u; cnt = 0u; mine = 0u;
#pragma unroll
        for (unsigned j = 0; j < 16; ++j) { const unsigned c = xb_ld(&bar[XB_XCNT(j)]); sum += c; cnt += (c > 0u) ? 1u : 0u; mine = (j == x) ? c : mine; }
        if (sum == G) break;
        __builtin_amdgcn_s_sleep(1);
        if ((++sp & 255u) == 0u) { if (xb_ld(&bar[XB_TMO])) break; if (sp > XB_SPIN_CAP) { atomicAdd(&bar[XB_TMO], 1u); break; } }
    }
    nloc = mine > 0u ? mine : 1u; nx = cnt > 0u ? cnt : 1u;
}

__device__ __forceinline__ void xcd_barrier(const XcdBarrier& b) {
    asm volatile("s_waitcnt vmcnt(0)" ::: "memory");
    __syncthreads();
    if (threadIdx.x == 0) {
        unsigned* bar = b.bar;
        __builtin_amdgcn_s_waitcnt(0);
        unsigned nloc = b.st[0], nx = b.st[1];
        if (nloc == 0u) { xcd_barrier_complete(bar, b.x, nloc, nx); b.st[0] = nloc; b.st[1] = nx; }
        const unsigned old = xb_add(&bar[XB_XSUB(b.x)], 1u);
        const unsigned gen = old / nloc;
        if (old + 1u == (gen + 1u) * nloc) {
            __builtin_amdgcn_fence(__ATOMIC_RELEASE, "agent");
            asm volatile("s_waitcnt vmcnt(0)" ::: "memory");
            const unsigned og = xb_add(&bar[XB_TOP], 1u);
            const unsigned tg = og / nx;
            if (og + 1u == (tg + 1u) * nx) xb_add(&bar[XB_TOPGEN], 1u);
            else XB_SPIN(xb_ld(&bar[XB_TOPGEN]) == tg, bar);
            __builtin_amdgcn_fence(__ATOMIC_ACQUIRE, "agent");
            xb_add(&bar[XB_XGEN(b.x)], 1u);
            asm volatile("s_waitcnt vmcnt(0)" ::: "memory");
        } else {
            XB_SPIN(xb_ld(&bar[XB_XGEN(b.x)]) == gen, bar);
            __builtin_amdgcn_fence(__ATOMIC_ACQUIRE, "agent");
            asm volatile("s_waitcnt vmcnt(0)" ::: "memory");
        }
    }
    __syncthreads();
}

template <int GS> __device__ __forceinline__ void group_barrier(unsigned* ctl, unsigned* bar, int vcu) {
    asm volatile("s_waitcnt vmcnt(0)" ::: "memory");
    __syncthreads();
    if (threadIdx.x == 0) {
        unsigned* w = ctl + 64 * (vcu / GS);
        __builtin_amdgcn_s_waitcnt(0);
        const unsigned id0 = xb_ld(&w[1]); bool same = (id0 != 0u);
#pragma unroll
        for (int m = 1; m < GS; ++m) same = same && (xb_ld(&w[1 + m]) == id0);
        if (!same) { __builtin_amdgcn_fence(__ATOMIC_RELEASE, "agent"); asm volatile("s_waitcnt vmcnt(0)" ::: "memory"); }
        (void)xb_add(&w[0], 1u);
        XB_SPIN(xb_ld(&w[0]) < (unsigned)GS, bar);
        __builtin_amdgcn_fence(__ATOMIC_ACQUIRE, "agent");
        asm volatile("s_waitcnt vmcnt(0)" ::: "memory");
    }
    __syncthreads();
}

struct Frame {
    LAS unsigned char* lds;
    int wave;
    int vcu, G;
};
__device__ const float INVF[16] = {1.000000000e+00f, 5.623413324e-01f, 3.162277639e-01f, 1.778279394e-01f, 1.000000015e-01f, 5.623413250e-02f, 3.162277490e-02f, 1.778279431e-02f,
                                   9.999999776e-03f, 5.623413250e-03f, 3.162277630e-03f, 1.778279431e-03f, 1.000000047e-03f, 5.623413017e-04f, 3.162277571e-04f, 1.778279402e-04f};

__device__ __forceinline__ void p0_transpose_item(const float* W, int K, int Nsrc, int src_col0, int nvalid, const float* kscale, bf16* WT, int dst_row0, LAS float* scr, int kb, int lane, int dk0 = -1, float cs = 1.f) {
    const int k0 = 64 * kb, c = lane & 31; if (dk0 < 0) dk0 = k0;
#pragma unroll 32
    for (int i = 0; i < 32; ++i) { const int kk = 2 * i + (lane >> 5); float v = 0.f; if (c < nvalid) v = W[(size_t)(k0 + kk) * Nsrc + src_col0 + c]; if (kscale) v *= kscale[k0 + kk]; scr[kk * 33 + c] = v * cs; }
    LDS_WAIT(); asm volatile("" ::: "memory");
    const int ch = lane & 7;
#pragma unroll
    for (int j = 0; j < 4; ++j) { const int n = (lane >> 3) + 8 * j; const LAS float* s = scr + (8 * ch) * 33 + n;
        v4u o; o.x = pk2(s[0 * 33], s[1 * 33]); o.y = pk2(s[2 * 33], s[3 * 33]); o.z = pk2(s[4 * 33], s[5 * 33]); o.w = pk2(s[6 * 33], s[7 * 33]);
        *(GAS v4u*)(WT + (size_t)(dst_row0 + n) * K + dk0 + 8 * ch) = o; }
    LDS_WAIT(); asm volatile("" ::: "memory");
}
__device__ __forceinline__ void win_block_src(int nb, int& src, int& nvalid) {
    const int tile = nb >> 3, blk = nb & 7, bj = blk >> 2, wc = blk & 3; nvalid = 32;
    if (tile < 2) src = OC_QB + tile * 256 + 64 * wc + 32 * bj;
    else if (tile < 4) src = OC_KB + (tile - 2) * 256 + 64 * wc + 32 * bj;
    else if (tile < 6) src = OC_VB + (tile - 4) * 256 + 32 * blk;
    else if (tile < 8) src = OC_GA + (tile - 6) * 256 + 32 * blk;
    else if (tile < 10) src = OC_GB + (tile - 8) * 256 + 32 * blk;
    else if (tile < 18) src = (bj ? OC_MB : OC_MA) + (tile - 10) * 128 + 32 * wc;
    else if (tile == 18) src = OC_CKV + 32 * blk;
    else if (tile == 19) src = OC_CQ + 32 * blk;
    else { if (blk < 4) src = OC_CQ + 256 + 32 * blk; else if (blk == 4) src = OC_KR; else if (blk == 5) { src = OC_FB; nvalid = 8; } else { src = 0; nvalid = 0; } }
}
struct Args { const float* in[21]; float* out; unsigned char* ws; int ph_lo, ph_hi, li, pad; };

__device__ __forceinline__ float wave_sum(float v) {
#pragma unroll
    for (int o = 1; o < 64; o <<= 1) v += __shfl_xor(v, o);
    return v;
}

__device__ __forceinline__ void p0_prologue(Frame& F, const Args& a) {
    unsigned char* ws = a.ws; const int lane = pg8::lane_id_asm(), tid = F.wave * 64 + lane;
    LAS float* scr = (LAS float*)(F.lds + RING_OFF + F.wave * 16384);
    const int gw = F.vcu * NWAVES + F.wave, NGW = F.G * NWAVES;
    const float *w_in = a.in[6], *w_uq = a.in[10], *w_ukv = a.in[11], *w_a = a.in[18], *w_b = a.in[19], *w_out = a.in[20];
    bf16 *Win_t = (bf16*)(ws + WSO_WIN), *Wuq_t = (bf16*)(ws + WSO_WUQ), *Wukv_t = (bf16*)(ws + WSO_WUKV), *Wcat_t = (bf16*)(ws + WSO_WCAT), *Wout_t = (bf16*)(ws + WSO_WOUT);
    constexpr int I_IN = 16 * 168, I_UQ = 6 * 24, I_UKV = 4 * 32, I_A = 8 * 32, I_B = 8 * 32, I_OUT = 16 * 32;
    constexpr int NITEMS = I_IN + I_UQ + I_UKV + I_A + I_B + I_OUT;
    for (int it = gw; it < NITEMS; it += NGW) {
        int r = it;
        if (r < I_IN) { const int kb = r / 168, nb = r % 168; int src, nv; win_block_src(nb, src, nv);
            const int tl_ = nb >> 3; const float cs_ = (tl_ >= 10 && tl_ < 18) ? -LOG2E : 1.f;
            p0_transpose_item(w_in, 1024, DIN, src, nv, nullptr, Win_t, nb * 32, scr, kb, lane, -1, cs_); continue; } r -= I_IN;
        if (r < I_UQ) { const int kb = r / 24, nb = r % 24, tile = nb >> 3, blk = nb & 7, bj = blk >> 2, wc = blk & 3;
            const int src = (tile < 2) ? (4 * tile + wc) * 96 + 32 * bj : (4 * bj + wc) * 96 + 64;
            p0_transpose_item(w_uq, 384, 768, src, 32, a.in[8], Wuq_t, nb * 32, scr, kb, lane); continue; } r -= I_UQ;
        if (r < I_UKV) { const int kb = r / 32, nb = r % 32, tile = nb >> 3, blk = nb & 7, bj = blk >> 2, wc = blk & 3;
            const int src = (tile < 2) ? (4 * tile + wc) * 128 + 32 * bj : (4 * (tile - 2) + (blk >> 1)) * 128 + 64 + 32 * (blk & 1);
            p0_transpose_item(w_ukv, 256, 1024, src, 32, a.in[9], Wukv_t, nb * 32, scr, kb, lane); continue; } r -= I_UKV;
        if (r < I_A) { p0_transpose_item(w_a, 1024, 1024, (r % 32) * 32, 32, nullptr, Wcat_t, (r % 32) * 32, scr, r / 32, lane, 64 * (r / 32)); continue; } r -= I_A;
        if (r < I_B) { p0_transpose_item(w_b, 1024, 1024, (r % 32) * 32, 32, nullptr, Wcat_t, (r % 32) * 32, scr, r / 32, lane, 512 + 64 * (r / 32)); continue; } r -= I_B;
        p0_transpose_item(w_out, 1024, 1024, (r % 32) * 32, 32, nullptr, Wout_t, (r % 32) * 32, scr, r / 32, lane);
    }
    if (gw == 0) { float* PAR = (float*)(ws + WSO_PAR); const int l = lane;
        PAR[PAR_QNB + l] = a.in[16][l]; PAR[PAR_KNB + l] = a.in[17][l]; PAR[PAR_QNNOPE + l] = a.in[12][l]; PAR[PAR_KNNOPE + l] = a.in[14][l];
        if (l < 32) { PAR[PAR_KNROPE + l] = a.in[15][l]; PAR[PAR_QNROPE + l] = a.in[13][l]; }
        if (l < 8) PAR[PAR_BF + l] = a.in[7][l];
        float mqb = fabsf(a.in[16][l]), mkb = fabsf(a.in[17][l]), mqn = fabsf(a.in[12][l]), mkn = fabsf(a.in[14][l]), mqr = fabsf(a.in[13][l & 31]), mkr = fabsf(a.in[15][l & 31]);
#pragma unroll
        for (int o = 1; o < 64; o <<= 1) { mqb = fmaxf(mqb, __shfl_xor(mqb, o)); mkb = fmaxf(mkb, __shfl_xor(mkb, o)); mqn = fmaxf(mqn, __shfl_xor(mqn, o)); mkn = fmaxf(mkn, __shfl_xor(mkn, o)); mqr = fmaxf(mqr, __shfl_xor(mqr, o)); mkr = fmaxf(mkr, __shfl_xor(mkr, o)); }
        if (l == 0) { PAR[PAR_BNDB] = 64.f * mqb * mkb * C2B * 1.02f; PAR[PAR_BNDA] = (64.f * mqn * mkn + 32.f * mqr * mkr) * C2A * 1.02f; } }
    { const int* pos = (const int*)a.in[2]; float* COS = (float*)(ws + WSO_COS); float* SIN = (float*)(ws + WSO_SIN);
      const int gt = F.vcu * (NWAVES * 64) + tid, NGT = F.G * NWAVES * 64;
      for (int e = gt; e < MTOK * 16; e += NGT) { const float ang = (float)pos[e >> 4] * INVF[e & 15]; COS[e] = cosf(ang); SIN[e] = sinf(ang); } }
}
__device__ __forceinline__ void p0_ada(Frame& F, const Args& a) {
    const int lane = pg8::lane_id_asm(), tid = F.wave * 64 + lane;
    const float *c = a.in[1], *w_ada = a.in[3], *b_ada = a.in[4]; float* ADA = (float*)(a.ws + WSO_ADA);
    LAS float* part = (LAS float*)(F.lds + RING_OFF);
    for (int item = F.vcu; item < 192; item += F.G) { const int cb = item % 48, bg = item / 48, k0 = 128 * F.wave;
        __syncthreads();
        const float* wp = w_ada + (size_t)k0 * 3072 + 64 * cb + lane; const float* cr = c + (size_t)(8 * bg) * 1024 + k0;
        float acc[8];
#pragma unroll
        for (int i = 0; i < 8; ++i) acc[i] = 0.f;
#pragma unroll 2
        for (int k = 0; k < 128; k += 8) { float wv[8];
#pragma unroll
            for (int u = 0; u < 8; ++u) wv[u] = wp[(size_t)(k + u) * 3072];
#pragma unroll
            for (int i = 0; i < 8; ++i)
#pragma unroll
                for (int u = 0; u < 8; ++u) acc[i] = fmaf(cr[i * 1024 + k + u], wv[u], acc[i]); }
#pragma unroll
        for (int i = 0; i < 8; ++i) part[(F.wave * 8 + i) * 64 + lane] = acc[i];
        __syncthreads();
        { const int i = tid >> 6, l = tid & 63; float s = 0.f;
#pragma unroll
          for (int w = 0; w < 8; ++w) s += part[(w * 8 + i) * 64 + l];
          ADA[(size_t)(8 * bg + i) * 3072 + 64 * cb + l] = s + b_ada[64 * cb + l]; }
    }
    __syncthreads();
}
__device__ __forceinline__ unsigned xn_swap1(unsigned v) { const int x_ = (int)v; return (unsigned)__builtin_amdgcn_update_dpp(x_, x_, 0xB1, 0xf, 0xf, false); }
__device__ __forceinline__ void p1_xn(Frame& F, const Args& a) {
    const int lane = pg8::lane_id_asm(); const bool odd = (lane & 1) != 0;
    const float *x = a.in[0], *nw = a.in[5]; const float* ADA = (const float*)(a.ws + WSO_ADA); bf16* XN = (bf16*)(a.ws + WSO_XN);
    const int gw = F.vcu * NWAVES + F.wave, NGW = F.G * NWAVES;
    for (int chunk = gw; chunk < MTOK / 32; chunk += NGW) { const int m0 = chunk * 32; const float* ad = ADA + (size_t)(m0 >> 11) * 3072;
        f32x4 g[4], sh[4];
#pragma unroll
        for (int j = 0; j < 4; ++j) { const int col = 4 * lane + 256 * j; g[j] = *(const f32x4*)(nw + col) * (*(const f32x4*)(ad + 1024 + col) + 1.0f); sh[j] = *(const f32x4*)(ad + col); }
        f32x4 va[4], vb[4];
#define XN_LOAD(buf, mm) do { const GAS f32x4* xr_ = (const GAS f32x4*)(x + (size_t)(mm) * DMODEL) + lane; _Pragma("unroll") for (int j = 0; j < 4; ++j) buf[j] = __builtin_nontemporal_load(xr_ + 64 * j); } while (0)
#define XN_ROW(buf, mm, nxt_ok, nxt_m) do { const int m = (mm); \
            f32x4 v[4]; float s = 0.f; \
            _Pragma("unroll") for (int j = 0; j < 4; ++j) { v[j] = buf[j]; s += (v[j].x * v[j].x + v[j].y * v[j].y) + (v[j].z * v[j].z + v[j].w * v[j].w); } \
            if (nxt_ok) XN_LOAD(buf, nxt_m); \
            const float rstd = rsqrtf(wave_sum(s) * (1.f / DMODEL) + EPS); \
            unsigned plo[4], phi[4]; \
            _Pragma("unroll") for (int j = 0; j < 4; ++j) { const f32x4 h = v[j] * rstd * g[j] + sh[j]; plo[j] = pg8::cvt_pk_bf16(h.x, h.y); phi[j] = pg8::cvt_pk_bf16(h.z, h.w); } \
            bf16* orow = XN + (size_t)m * DMODEL + 4 * (lane & ~1); \
            _Pragma("unroll") for (int jp = 0; jp < 2; ++jp) { const int j0 = 2 * jp, j1 = 2 * jp + 1; \
                const unsigned r0_ = xn_swap1(odd ? plo[j0] : plo[j1]), r1_ = xn_swap1(odd ? phi[j0] : phi[j1]);        \
                v4u o; if (odd) { o.x = r0_; o.y = r1_; o.z = plo[j1]; o.w = phi[j1]; } else { o.x = plo[j0]; o.y = phi[j0]; o.z = r0_; o.w = r1_; } \
                *(GAS v4u*)(orow + 256 * (odd ? j1 : j0)) = o; } } while (0)
        f32x4 vc[4], vd[4];
        XN_LOAD(va, m0); XN_LOAD(vb, m0 + 1); XN_LOAD(vc, m0 + 2); XN_LOAD(vd, m0 + 3);
#pragma unroll 1
        for (int r = 0; r < 32; r += 4) {
            XN_ROW(va, m0 + r, r + 4 < 32, m0 + r + 4);
            XN_ROW(vb, m0 + r + 1, r + 5 < 32, m0 + r + 5);
            XN_ROW(vc, m0 + r + 2, r + 6 < 32, m0 + r + 6);
            XN_ROW(vd, m0 + r + 3, r + 7 < 32, m0 + r + 7);
        }
#undef XN_LOAD
#undef XN_ROW
    }
}

#ifndef ATT_FIXREF
#define ATT_FIXREF true
#endif
#ifndef P2_WGM
#define P2_WGM 4
#endif
#ifndef MLA_PIPE
#define MLA_PIPE 1
#endif
#ifndef PROBE_FORCE_FALLBACK
#define PROBE_FORCE_FALLBACK 0
#endif
#ifndef P56_GS
#define P56_GS 4
#endif
#ifndef PROBE_REPEAT
#define PROBE_REPEAT 0
#endif
#define P4_REPS (((PROBE_REPEAT >> 4) & 1) ? 2 : 1)
template <bool EARLY> __device__ __forceinline__ void p4_fast(const Frame& F, unsigned char* wsp, float bndb, float bnda, bool shared4, int nrounds) {
    typedef pg8::bf16_t hb;
#define WSP(off) (wsp + (off))
        if (!EARLY) __builtin_amdgcn_s_setprio(1);
        LAS unsigned char* al = F.lds + RING_OFF; const float* LOGF = (const float*)WSP(WSO_LOGF);
        hb *QB = (hb*)WSP(WSO_QB), *KB = (hb*)WSP(WSO_KB), *VB = (hb*)WSP(WSO_VB), *GB = (hb*)WSP(WSO_GB), *GA = (hb*)WSP(WSO_GA), *QAN = (hb*)WSP(WSO_QAN), *QAR = (hb*)WSP(WSO_QAR), *KAN = (hb*)WSP(WSO_KAN), *KROPE = (hb*)WSP(WSO_KROPE), *VA = (hb*)WSP(WSO_VA), *YCAT = (hb*)WSP(WSO_YCAT);
        LAS int* hperm = (LAS int*)(F.lds + MISC_OFF) + 16; LAS const int* jmtab = (LAS const int*)(F.lds + MISC_OFF) + 40;
        attp::bf16x8 qx[6];
#pragma unroll
        for (int d0 = 0; d0 < 6; ++d0) asm volatile("" : "=v"(qx[d0]));
        int ring_s0 = 0; bool ring_pre = false;
        const float t0thr = 130.f + bndb;
#define P4_JM(rr) (jmtab[(((F.vcu >> 2) & 1) * 4 + ((rr) & 3)) * 4 + (F.vcu & 3)])
        for (int rep = 0; rep < P4_REPS; ++rep) {
        int t0first = 0;
        { const int bh00 = shared4 ? (F.vcu >> 2) * 4 : (int)blockIdx.x;
          if (bh00 < BATCH * NH) { const int bhp = shared4 ? (bh00 & ~7) + hperm[bh00 & 7] : bh00;
              __syncthreads();
              att::fox_cum<false>(LOGF, bhp >> 3, bhp & 7, (LAS float*)(al + attp::LDS_CUM), (LAS float*)(al + attp::LDS_TMP), F.wave);
              { const int qbf = shared4 ? P4_JM(0) : 0; t0first = attp::fox_t0((LAS const float*)(al + attp::LDS_CUM), qbf * attp::QB, 4 * qbf + 4, t0thr); } } }
        for (int r = 0; r < nrounds; ++r) {
            const int bh0 = shared4 ? (F.vcu >> 2) * 4 + r : (int)blockIdx.x + r * F.G; if (bh0 >= BATCH * NH) break;
            const int bh = shared4 ? (bh0 & ~7) + hperm[bh0 & 7] : bh0;
            const int b = bh >> 3, h = bh & 7, jm = P4_JM(r), nq = shared4 ? 2 : 8, cb = r & 1;
            { const attp::Tensors Tf{QB, nullptr, KB, nullptr, VB, GB, YCAT + 512, 1024}, Tm{QAN, QAR, KAN, KROPE, VA, GA, YCAT, 1024};
              const int bhn0 = shared4 ? bh0 + 1 : bh0 + F.G; const bool more = (r + 1 < nrounds) && (bhn0 < BATCH * NH);
              const int bhn = (shared4 && more) ? (bhn0 & ~7) + hperm[bhn0 & 7] : bhn0;
              int t0cur = t0first;
              for (int iq = 0; iq < nq; ++iq) { const int qb = shared4 ? (iq == 0 ? jm : 7 - jm) : iq; const bool lastq = (iq + 1 == nq);
                  const int iqn = lastq ? 0 : iq + 1, qbn = shared4 ? (iqn == 0 ? jm : 7 - jm) : iqn;
                  const int t0n = lastq ? 0 : attp::fox_t0((LAS const float*)(al + attp::LDS_CUM + cb * 8192), qbn * attp::QB, 4 * qbn + 4, t0thr);
                  ring_s0 = attp::attn_unit<0, 8, true, EARLY>(b, h, qb, Tf, al, F.wave, bndb, ring_s0, ring_pre, lastq ? 1 : 0, wsp, b, h, qbn, qx, t0cur, t0n, cb);
                  t0cur = t0n; ring_pre = true; }
              if (more) {
                  att::fox_cum<true>(LOGF, bhn >> 3, bhn & 7, (LAS float*)(al + attp::LDS_CUM + (cb ^ 1) * 8192), (LAS float*)(al + attp::LDS_TMP), F.wave);
                  { const int qbf = shared4 ? P4_JM(r + 1) : 0; t0first = attp::fox_t0((LAS const float*)(al + attp::LDS_CUM + (cb ^ 1) * 8192), qbf * attp::QB, 4 * qbf + 4, t0thr); } }
              for (int iq = 0; iq < nq; ++iq) { const int qb = shared4 ? (iq == 0 ? jm : 7 - jm) : iq; const bool lastq = (iq + 1 == nq);
                  const int nmode = lastq ? (more ? 0 : -1) : 1; const int bn = lastq ? (bhn >> 3) : b, hn = lastq ? (bhn & 7) : h;
                  const int iqn = lastq ? 0 : iq + 1, qbn = shared4 ? (lastq ? P4_JM(r + 1) : 7 - jm) : iqn;
                  ring_s0 = attp::attn_unit<1, 8, true, EARLY>(b, h, qb, Tm, al, F.wave, bnda, ring_s0, ring_pre, nmode, wsp, bn, hn, qbn, qx, 0, (lastq && more) ? t0first : 0, cb);
                  ring_pre = (nmode >= 0); } }
        }
        }
        if (!EARLY) __builtin_amdgcn_s_setprio(0);
#undef WSP
#undef P4_JM
}

__global__ void __launch_bounds__(NWAVES * 64, 2) mk_fwd(Args args) {
    extern __shared__ __attribute__((aligned(16))) unsigned char lds[];
    Frame F;
    F.lds = (LAS unsigned char*)lds;
    F.wave = __builtin_amdgcn_readfirstlane(threadIdx.x >> 6);
    F.G = gridDim.x; { const int bx = blockIdx.x; F.vcu = (F.G % 8 == 0) ? (bx % 8) * (F.G / 8) + bx / 8 : bx; }
    for (int u = threadIdx.x; u < (LDS_BYTES - LDSCTL_OFF) / 4; u += NWAVES * 64) ((LAS unsigned*)(F.lds + LDSCTL_OFF))[u] = 0u;
    __syncthreads();
    if (N_LAUNCHES == 1 && threadIdx.x == 0) ((gu32*)(args.ws + WSO_CTL))[64 * (F.vcu / P56_GS) + 1 + (F.vcu % P56_GS)] = xb_xcc_id() + 1u;
    if (N_LAUNCHES == 1) (void)xcd_barrier_post((unsigned*)((gu32*)(args.ws + WSO_CTL) + CW_BAR), (volatile LAS unsigned*)(F.lds + MISC_OFF) + 8);
#define GRID_BAR() do { if (N_LAUNCHES == 1) { XcdBarrier b_; b_.bar = (unsigned*)((gu32*)(args.ws + WSO_CTL) + CW_BAR); b_.x = xb_xcc_id(); b_.st = (volatile LAS unsigned*)(F.lds + MISC_OFF) + 8; xcd_barrier(b_); } } while (0)
    const int lo = args.ph_lo, hi = args.ph_hi;
#ifndef PHASE_MASK
#define PHASE_MASK 0x7f
#endif
#define IN(k) (((PHASE_MASK >> (k)) & 1) && lo <= (k) && (k) < hi)
#define BOTH(k) (IN(k) && IN((k) + 1))
#ifndef PROBE_REPEAT
#define PROBE_REPEAT 0
#endif
#define REPS(k) (((PROBE_REPEAT >> (k)) & 1) ? 2 : 1)
    typedef pg8::bf16_t hb;
#define WSP(off) (wsp + (off))
#define PHASE_WS() unsigned long long z_ = 0; asm volatile("" : "+s"(z_)); unsigned char* wsp = args.ws + z_
    if (IN(0)) { for (int rep = 0; rep < REPS(0); ++rep) p0_ada(F, args); if (BOTH(0)) GRID_BAR(); }
    if (IN(1)) { for (int rep = 0; rep < REPS(1); ++rep) { p0_prologue(F, args); p1_xn(F, args); } if (BOTH(1)) GRID_BAR(); }
    if (IN(2)) { PHASE_WS();
      for (int rep = 0; rep < REPS(2); ++rep) {
        pg8::Gemm g{(hb*)WSP(WSO_XN), (hb*)WSP(WSO_WIN), MTOK, NIN, 1024}; pg8::StaticOrder S; S.init(MTOK, NIN, F.G, (int)blockIdx.x, P2_WGM);
        pg8::EpiIn E{wsp};
        pg8::gemm_phase<pg8::EpiIn, pg8::StaticOrder, true, true, 2>(F.lds + RING_OFF, g, S, E, F.wave); }
        if (BOTH(2)) GRID_BAR();
    }
    if (IN(3)) { PHASE_WS();
      for (int rep = 0; rep < REPS(3); ++rep) {
        { pg8::Gemm g{(hb*)WSP(WSO_CQ), (hb*)WSP(WSO_WUQ), MTOK, 768, 384}; pg8::StaticOrder S; S.init(MTOK, 768, F.G, (int)blockIdx.x);
          pg8::EpiQup E{wsp};
          pg8::gemm_phase<pg8::EpiQup, pg8::StaticOrder, true, true>(F.lds + RING_OFF, g, S, E, F.wave); }
        { pg8::Gemm g{(hb*)WSP(WSO_CKV), (hb*)WSP(WSO_WUKV), MTOK, 1024, 256}; pg8::StaticOrder S; S.init(MTOK, 1024, F.G, (int)blockIdx.x);
          pg8::EpiKVup E{wsp};
          pg8::gemm_phase<pg8::EpiKVup, pg8::StaticOrder, true, true>(F.lds + RING_OFF, g, S, E, F.wave); } }
        if (BOTH(3)) GRID_BAR();
    }
    if (IN(4)) { PHASE_WS();
        LAS unsigned char* al = F.lds + RING_OFF; const float* LOGF = (const float*)WSP(WSO_LOGF);
        hb *QB = (hb*)WSP(WSO_QB), *KB = (hb*)WSP(WSO_KB), *VB = (hb*)WSP(WSO_VB), *GB = (hb*)WSP(WSO_GB), *GA = (hb*)WSP(WSO_GA), *QAN = (hb*)WSP(WSO_QAN), *QAR = (hb*)WSP(WSO_QAR), *KAN = (hb*)WSP(WSO_KAN), *KROPE = (hb*)WSP(WSO_KROPE), *VA = (hb*)WSP(WSO_VA), *YCAT = (hb*)WSP(WSO_YCAT);
        const float bndb = ((const float*)WSP(WSO_PAR))[PAR_BNDB], bnda = ((const float*)WSP(WSO_PAR))[PAR_BNDA];
        const bool fastref = ATT_FIXREF && bndb <= 80.f && bnda <= 80.f && (PROBE_FORCE_FALLBACK == 0);
        const bool shared4 = (F.G == 256);
        const int nrounds = shared4 ? 4 : (BATCH * NH + F.G - 1) / F.G;
        if (fastref) {
        LAS int* hperm = (LAS int*)(F.lds + MISC_OFF) + 16;
        if (threadIdx.x == 0) { LAS float* bs = (LAS float*)(F.lds + MISC_OFF) + 24; const float* bfp = (const float*)WSP(WSO_PAR) + PAR_BF; int idx[8];
            for (int i = 0; i < 8; ++i) bs[i] = bfp[i];
            unsigned used = 0u; LAS int* srt = (LAS int*)(F.lds + MISC_OFF) + 32;
            for (int i = 0; i < 8; ++i) { int best = -1; float bv = 0.f; for (int j = 0; j < 8; ++j) if (!((used >> j) & 1u) && (best < 0 || bs[j] < bv)) { best = j; bv = bs[j]; } used |= 1u << best; srt[i] = best; }
            (void)idx; hperm[0] = srt[0]; hperm[1] = srt[3]; hperm[2] = srt[4]; hperm[3] = srt[7]; hperm[4] = srt[1]; hperm[5] = srt[2]; hperm[6] = srt[5]; hperm[7] = srt[6];
            LAS int* jt = (LAS int*)(F.lds + MISC_OFF) + 40; LAS float* ld = (LAS float*)(F.lds + MISC_OFF) + 72; LAS int* ord = (LAS int*)(F.lds + MISC_OFF) + 76;
            const float thr_ = 130.f + bndb;
            for (int st = 0; st < 2; ++st) { for (int j = 0; j < 4; ++j) ld[j] = 0.f;
                for (int r = 0; r < 4; ++r) { const float bb = bs[hperm[st * 4 + r]];
                    const float d = __log2f(1.f + __expf(-bb)); float W = (d > 1e-6f) ? thr_ / (64.f * d) : 64.f; if (W > 64.f) W = 64.f;
                    unsigned usd = 0u;
                    for (int k = 0; k < 4; ++k) { int best = -1; float bv = 0.f; for (int j = 0; j < 4; ++j) if (!((usd >> j) & 1u) && (best < 0 || ld[j] > bv)) { best = j; bv = ld[j]; } usd |= 1u << best; ord[k] = best; }
                    for (int k = 0; k < 4; ++k) { const int j = ord[k]; const float c0 = fminf(4.f * k + 4.f, W + 5.f), c1 = fminf(4.f * (7 - k) + 4.f, W + 5.f);
                        jt[(st * 4 + r) * 4 + j] = k; ld[j] += c0 + c1; } } } }
        __syncthreads();
        if (F.wave < 4) p4_fast<true>(F, wsp, bndb, bnda, shared4, nrounds); else p4_fast<false>(F, wsp, bndb, bnda, shared4, nrounds);
        } else {
        for (int r = 0; r < nrounds; ++r) {
            const int bh = shared4 ? (F.vcu >> 2) * 4 + r : (int)blockIdx.x + r * F.G; if (bh >= BATCH * NH) break;
            const int b = bh >> 3, h = bh & 7, jm = F.vcu & 3, nq = shared4 ? 2 : 8;
            __syncthreads();
            att::fox_cum<false>(LOGF, b, h, (LAS float*)(al + att::LDS_CUM), (LAS float*)(al + att::LDS_TMP), F.wave);
            const att::Tensors Tf{QB, nullptr, KB, nullptr, VB, GB, YCAT + 512, 1024}, Tm{QAN, QAR, KAN, KROPE, VA, GA, YCAT, 1024};
            for (int iq = 0; iq < nq; ++iq) { const int qb = shared4 ? (iq == 0 ? jm : 7 - jm) : iq; att::attn_unit<0>(b, h, qb, Tf, al, F.wave); }
            for (int iq = 0; iq < nq; ++iq) { const int qb = shared4 ? (iq == 0 ? jm : 7 - jm) : iq; att::attn_unit<1>(b, h, qb, Tm, al, F.wave); }
        }
        }
        if (BOTH(4)) GRID_BAR();
    }
    const bool grouped = (N_LAUNCHES == 1) && (F.G == 256);
    if (IN(5)) { PHASE_WS();
      for (int rep = 0; rep < REPS(5); ++rep) {
        pg8::Gemm g{(hb*)WSP(WSO_YCAT), (hb*)WSP(WSO_WCAT), MTOK, 1024, 1024};
        pg8::EpiMerge E{wsp};
        if (grouped) { pg8::GroupOrder<P56_GS> S; S.init(F.vcu); pg8::gemm_phase<pg8::EpiMerge, pg8::GroupOrder<P56_GS>, true, true>(F.lds + RING_OFF, g, S, E, F.wave); }
        else { pg8::PanelOrder S; S.init(MTOK, 1024, F.G, (int)blockIdx.x); pg8::gemm_phase<pg8::EpiMerge, pg8::PanelOrder, true, true>(F.lds + RING_OFF, g, S, E, F.wave); } }
        if (grouped) group_barrier<P56_GS>((unsigned*)((gu32*)(args.ws + WSO_CTL)), (unsigned*)((gu32*)(args.ws + WSO_CTL) + CW_BAR), F.vcu);
        else {
        asm volatile("s_waitcnt vmcnt(0)" ::: "memory"); __syncthreads();
        if (threadIdx.x == 0) { __builtin_amdgcn_fence(__ATOMIC_ACQUIRE, "agent"); asm volatile("s_waitcnt vmcnt(0)" ::: "memory"); }
        __syncthreads(); }
    }
    if (IN(6)) { PHASE_WS();
      for (int rep = 0; rep < REPS(6); ++rep) {
        pg8::Gemm g{(hb*)WSP(WSO_MERGED), (hb*)WSP(WSO_WOUT), MTOK, 1024, 1024};
        pg8::EpiOut E{args.in[0], args.out, (const float*)WSP(WSO_ADA) + 2048};
        if (grouped) { pg8::GroupOrder<P56_GS> S; S.init(F.vcu); pg8::gemm_phase<pg8::EpiOut, pg8::GroupOrder<P56_GS>, true, true>(F.lds + RING_OFF, g, S, E, F.wave); }
        else { pg8::PanelOrder S; S.init(MTOK, 1024, F.G, (int)blockIdx.x); pg8::gemm_phase<pg8::EpiOut, pg8::PanelOrder, true, true>(F.lds + RING_OFF, g, S, E, F.wave); } }
    }
#undef IN
#undef BOTH
}

extern "C" void kernel_launch(void* const* d_in, const int* in_sizes, int n_in, void* d_out, int out_size, void* d_ws, size_t ws_size, hipStream_t stream) {
    static int grid = 0;
    if (grid == 0) {
        if (n_in != 21 || in_sizes[0] != MTOK * DMODEL || out_size != MTOK * DMODEL || ws_size < WSO_END) { fprintf(stderr, "kernel_launch: unexpected shapes: n_in %d in0 %d out %d ws %zu (need %zu)\n", n_in, n_in > 0 ? in_sizes[0] : -1, out_size, ws_size, (size_t)WSO_END); grid = -1; return; }
        int dev = 0, cus = 0, per_cu = 0;
        if (hipGetDevice(&dev) != hipSuccess || hipDeviceGetAttribute(&cus, hipDeviceAttributeMultiprocessorCount, dev) != hipSuccess) { fprintf(stderr, "kernel_launch: device query failed\n"); grid = -1; return; }
        if (hipFuncSetAttribute((const void*)mk_fwd, hipFuncAttributeMaxDynamicSharedMemorySize, LDS_BYTES) != hipSuccess) { fprintf(stderr, "kernel_launch: hipFuncSetAttribute failed\n"); grid = -1; return; }
        if (hipOccupancyMaxActiveBlocksPerMultiprocessor(&per_cu, (const void*)mk_fwd, NWAVES * 64, LDS_BYTES) != hipSuccess || per_cu < 1) fprintf(stderr, "kernel_launch: note: occupancy query reports %d workgroups per CU\n", per_cu);
        (void)hipGetLastError();
        grid = cus;
    }
    if (grid < 0) return;
    if (hipMemsetAsync((char*)d_ws + WSO_CTL, 0, CTL_ZERO_BYTES, stream) != hipSuccess) { fprintf(stderr, "kernel_launch: memset failed\n"); return; }
    Args a{};
    for (int i = 0; i < 21; ++i) a.in[i] = (const float*)d_in[i];
    a.out = (float*)d_out; a.ws = (unsigned char*)d_ws;
    for (int li = 0; li < N_LAUNCHES; ++li) {
        a.ph_lo = (N_LAUNCHES == 1) ? 0 : li; a.ph_hi = (N_LAUNCHES == 1) ? N_PHASES : li + 1; a.li = li;
        hipLaunchKernelGGL(mk_fwd, dim3(grid), dim3(NWAVES * 64), LDS_BYTES, stream, a);
        const hipError_t le = hipPeekAtLastError();
        if (le != hipSuccess) { fprintf(stderr, "kernel_launch: launch %d failed: %s\n", li, hipGetErrorName(le)); break; }
    }
}
```

```cpp
#include <hip/hip_runtime.h>
#include <hip/hip_bf16.h>
#include <cstdio>
#include <cstdint>
#include <cmath>

constexpr int BATCH = 32, SEQ = 2048, DMODEL = 1024, MTOK = BATCH * SEQ;
constexpr int QLORA = 384, KVLORA = 256, ROPE = 32, NH = 8, HD = 64;
constexpr int DIN = 5288, NIN = 5376;
constexpr float EPS = 1e-6f;
constexpr float LOG2E = 1.4426950408889634f;
constexpr float C2B = 0.125f * LOG2E;
constexpr float C2A = 0.10206207261596575f * LOG2E;
constexpr int OC_CQ = 0, OC_CKV = 384, OC_KR = 640, OC_GA = 672, OC_QB = 1184, OC_KB = 1696, OC_VB = 2208, OC_FB = 2720, OC_GB = 2728, OC_MA = 3240, OC_MB = 4264;

constexpr size_t MiB = 1u << 20;
constexpr size_t WSO_CTL = 0, CTL_ZERO_BYTES = 32 * 1024;
constexpr size_t WSO_WIN = 2 * MiB, WSO_WUQ = 13 * MiB, WSO_WUKV = 14 * MiB, WSO_WCAT = 15 * MiB, WSO_WOUT = 17 * MiB;
constexpr size_t WSO_ADA = 19 * MiB, WSO_COS = 20 * MiB, WSO_SIN = 24 * MiB, WSO_LOGF = 28 * MiB, WSO_SSQQ = 30 * MiB, WSO_SSQKV = 32 * MiB, WSO_KROPE = 34 * MiB, WSO_PAR = 38 * MiB;
constexpr size_t WSO_XN = 40 * MiB;
constexpr size_t WSO_QAN = WSO_XN, WSO_KAN = WSO_XN + 64 * MiB;
constexpr size_t WSO_CQ = 168 * MiB, WSO_CKV = 216 * MiB;
constexpr size_t WSO_YCAT = 168 * MiB;
constexpr size_t WSO_GA = 296 * MiB, WSO_QB = 360 * MiB, WSO_KB = 424 * MiB, WSO_VB = 488 * MiB, WSO_GB = 552 * MiB;
constexpr size_t WSO_MERGED = WSO_KB;
constexpr size_t WSO_RA = 616 * MiB, WSO_SB = 744 * MiB, WSO_QAR = 872 * MiB, WSO_VA = 904 * MiB, WSO_END = 968 * MiB;
static_assert(WSO_WIN + (size_t)NIN * 1024 * 2 <= WSO_WUQ && WSO_SSQKV + (size_t)MTOK * 16 <= WSO_KROPE && WSO_KROPE + (size_t)MTOK * 64 <= WSO_PAR, "d_ws map");
constexpr int PAR_QNB = 0, PAR_KNB = 64, PAR_KNROPE = 128, PAR_BF = 160, PAR_QNNOPE = 192, PAR_QNROPE = 256, PAR_KNNOPE = 320, PAR_BNDB = 384, PAR_BNDA = 385, PAR_N = 448;

namespace pg8 {
#define PG8_LAS __attribute__((address_space(3)))
typedef unsigned short bf16_t;
typedef short bf16x8 __attribute__((ext_vector_type(8)));
typedef float f32x4 __attribute__((ext_vector_type(4)));
typedef unsigned u32x4 __attribute__((ext_vector_type(4)));
constexpr int BM = 256, BK = 64, HALF = 128, HTB = HALF * BK * 2  , STAGE_BYTES = 8 * HTB, NXCD = 8, WGM = 8;

__host__ __device__ __forceinline__ int lds_byte(int r, int c) { const int st = (r >> 4) * 2 + (c >> 5), rr = r & 15, cc = c & 31, ob = rr * 64 + cc * 2; return st * 1024 + (ob ^ (((ob >> 9) & 1) << 5)); }
__host__ __device__ __forceinline__ void stage_rc(int b, int& R, int& C) { const int st = b / 1024, sb = b % 1024, swz = sb ^ (((sb >> 9) & 1) << 5); R = (st >> 1) * 16 + swz / 64; C = (st & 1) * 32 + (swz % 64) / 2; }
__host__ __device__ __forceinline__ int perm32(int rho) { const int n = rho >> 4, i = rho & 15; return 8 * (i >> 2) + 4 * n + (i & 3); }

struct Unit { int pm, pn; };
struct Gemm { const bf16_t* A; const bf16_t* Bt; int M, N, K; };

struct StaticOrder {
    int nM, nN, nwg, G, c, wgm;
    __host__ __device__ void init(int M, int N, int G_, int c_, int wgm_ = WGM) { nM = M / BM; nN = N / BM; nwg = nM * nN; G = G_; c = c_; wgm = wgm_; }
    __host__ __device__ bool next(int i, Unit& u) const {
        const long L = (long)i * G + c; if (L >= nwg) return false;
        int wgid = (int)L; { const int q = nwg / NXCD, r = nwg % NXCD, xcd = wgid % NXCD, off = wgid / NXCD; wgid = (xcd < r ? xcd * (q + 1) : r * (q + 1) + (xcd - r) * q) + off; }
        const int nig = wgm * nN, gid = wgid / nig, fm = gid * wgm, gsz = (nM - fm) < wgm ? (nM - fm) : wgm;
        u.pm = fm + ((wgid % nig) % gsz); u.pn = (wgid % nig) / gsz; if (gid & 1) u.pn = nN - 1 - u.pn;
        return true;
    }
    __device__ __forceinline__ void a_ready(const Unit&) const {}
    __device__ __forceinline__ void done(const Unit&) const {}
};

__device__ __forceinline__ unsigned cvt_pk_bf16(float lo, float hi) { unsigned r; asm volatile("v_cvt_pk_bf16_f32 %0, %1, %2" : "=v"(r) : "v"(lo), "v"(hi)); return r; }
typedef float f32x2 __attribute__((ext_vector_type(2)));
__device__ __forceinline__ int lane_id_asm() { int l; asm volatile("v_mbcnt_lo_u32_b32 %0, -1, 0\n\tv_mbcnt_hi_u32_b32 %0, -1, %0" : "=v"(l)); return l; }

__device__ __forceinline__ float silu_f(float z) { return z * __builtin_amdgcn_rcpf(1.f + __expf(-z)); }
__device__ __forceinline__ float sigm_f(float z) { return __builtin_amdgcn_rcpf(1.f + __expf(-z)); }
__device__ __forceinline__ u32x4 pack8(const f32x4 a, const f32x4 b) { u32x4 w; w.x = cvt_pk_bf16(a[0], a[1]); w.y = cvt_pk_bf16(a[2], a[3]); w.z = cvt_pk_bf16(b[0], b[1]); w.w = cvt_pk_bf16(b[2], b[3]); return w; }
__device__ __forceinline__ float bf_lo(unsigned u) { return __uint_as_float(u << 16); }
__device__ __forceinline__ float bf_hi(unsigned u) { return __uint_as_float(u & 0xffff0000u); }
__device__ __forceinline__ float sq4(const f32x4 x) { return (x[0] * x[0] + x[1] * x[1]) + (x[2] * x[2] + x[3] * x[3]); }
__device__ __forceinline__ float red_fq(float s) { s += __shfl_xor(s, 16); s += __shfl_xor(s, 32); return s; }

template <int ACT, bool NT = true> __device__ __forceinline__ void epi_plain(const f32x4 (&acc)[2][2][4][2], int row0, int wc, int fq, bf16_t* dst, int ldc, int col_base) {
#pragma unroll
    for (int ai = 0; ai < 2; ++ai)
#pragma unroll
        for (int m = 0; m < 4; ++m) { bf16_t* rowp = dst + (size_t)(row0 + ai * HALF + m * 16) * ldc + col_base + wc * 32 + 8 * fq;
#pragma unroll
            for (int bj = 0; bj < 2; ++bj) { f32x4 v0 = acc[ai][bj][m][0], v1 = acc[ai][bj][m][1];
                if (ACT == 1) {
#pragma unroll
                    for (int e = 0; e < 4; ++e) { v0[e] = silu_f(v0[e]); v1[e] = silu_f(v1[e]); } }
                if (ACT == 2) {
#pragma unroll
                    for (int e = 0; e < 4; ++e) { v0[e] = sigm_f(v0[e]); v1[e] = sigm_f(v1[e]); } }
                if (NT) __builtin_nontemporal_store(pack8(v0, v1), (u32x4*)(rowp + bj * HALF)); else *(u32x4*)(rowp + bj * HALF) = pack8(v0, v1); } }
}
template <int NBJ> __device__ __forceinline__ void epi_ssq(const f32x4 (&acc)[2][2][4][2], int row0, int fq, float* ssq, int ld, int slot) {
#pragma unroll
    for (int ai = 0; ai < 2; ++ai)
#pragma unroll
        for (int m = 0; m < 4; ++m) { float s = 0.f;
#pragma unroll
            for (int bj = 0; bj < NBJ; ++bj) s += sq4(acc[ai][bj][m][0]) + sq4(acc[ai][bj][m][1]);
            s = red_fq(s);
            if (fq == 0) ssq[(size_t)(row0 + ai * HALF + m * 16) * ld + slot] = s; }
}
template <int NSLOT> __device__ __forceinline__ float row_rs(const float* ssq, int row, float inv_n) { const float* p = ssq + (size_t)row * NSLOT; float s = 0.f;
#pragma unroll
    for (int k = 0; k < NSLOT; k += 4) { const f32x4 v = *(const f32x4*)(p + k); s += (v[0] + v[1]) + (v[2] + v[3]); }
    return rsqrtf(s * inv_n + EPS); }
template <int NSLOT> __device__ __forceinline__ void epi_heads(const f32x4 (&acc)[2][2][4][2], int row0, int wc, int fq, bf16_t* dst, int ldc, int head0, const float* w, float wscale, const float* ssq, float inv_n) {
    f32x4 wv[2][2];
#pragma unroll
    for (int bj = 0; bj < 2; ++bj)
#pragma unroll
        for (int n = 0; n < 2; ++n) wv[bj][n] = *(const f32x4*)(w + 32 * bj + 8 * fq + 4 * n) * wscale;
#pragma unroll
    for (int ai = 0; ai < 2; ++ai)
#pragma unroll
        for (int m = 0; m < 4; ++m) { float s = 0.f;
#pragma unroll
            for (int bj = 0; bj < 2; ++bj) s += sq4(acc[ai][bj][m][0]) + sq4(acc[ai][bj][m][1]);
            s = red_fq(s);
            const float r = NSLOT ? row_rs<NSLOT ? NSLOT : 4>(ssq, row0 + ai * HALF + m * 16, inv_n) : 1.f;
            const float f = r * rsqrtf(s * r * r * (1.f / 64.f) + EPS);
            bf16_t* rowp = dst + (size_t)(row0 + ai * HALF + m * 16) * ldc + (head0 + wc) * 64 + 8 * fq;
#pragma unroll
            for (int bj = 0; bj < 2; ++bj) __builtin_nontemporal_store(pack8(acc[ai][bj][m][0] * f * wv[bj][0], acc[ai][bj][m][1] * f * wv[bj][1]), (u32x4*)(rowp + 32 * bj));
            asm volatile("" ::: "memory"); }
}
__device__ __forceinline__ void rope_group(const f32x4 x0, const f32x4 x1, float r, const f32x4 w0, const f32x4 w1, const float* cosr, const float* sinr, int fq, float oscale, bf16_t* outp) {
    float s = red_fq(sq4(x0) + sq4(x1));
    const float f = r * rsqrtf(s * r * r * (1.f / 32.f) + EPS);
    const f32x4 y0 = x0 * f * w0, y1 = x1 * f * w1;
    f32x4 p0, p1;
#pragma unroll
    for (int e = 0; e < 4; ++e) { p0[e] = __shfl_xor(y0[e], 32); p1[e] = __shfl_xor(y1[e], 32); }
    const int i0 = 8 * (fq & 1);
    const f32x4 c0 = *(const f32x4*)(cosr + i0), c1 = *(const f32x4*)(cosr + i0 + 4), s0 = *(const f32x4*)(sinr + i0), s1 = *(const f32x4*)(sinr + i0 + 4);
    const float sg = (fq < 2) ? -oscale : oscale;
    const f32x4 o0 = y0 * c0 * oscale + p0 * s0 * sg, o1 = y1 * c1 * oscale + p1 * s1 * sg;
    __builtin_nontemporal_store(pack8(o0, o1), (u32x4*)outp);
    asm volatile("" ::: "memory");
}

__device__ __forceinline__ void epi_mgates(const f32x4 (&acc)[2][2][4][2], int row0, int wc, int fq, bf16_t* RA, bf16_t* SB, int c0) {
#pragma unroll
    for (int ai = 0; ai < 2; ++ai)
#pragma unroll
        for (int m = 0; m < 4; ++m) { const size_t off = (size_t)(row0 + ai * HALF + m * 16) * 1024 + c0 + wc * 32 + 8 * fq;
            f32x4 r0, r1, s0, s1;
#pragma unroll
            for (int e = 0; e < 4; ++e) { const float ea0 = 1.f + __expf(fminf(-acc[ai][0][m][0][e], 80.f)), ea1 = 1.f + __expf(fminf(-acc[ai][0][m][1][e], 80.f)), eb0 = 1.f + __expf(fminf(-acc[ai][1][m][0][e], 80.f)), eb1 = 1.f + __expf(fminf(-acc[ai][1][m][1][e], 80.f));
                r0[e] = eb0 * __builtin_amdgcn_rcpf(ea0); r1[e] = eb1 * __builtin_amdgcn_rcpf(ea1); s0[e] = __builtin_amdgcn_rcpf(eb0); s1[e] = __builtin_amdgcn_rcpf(eb1); }
            __builtin_nontemporal_store(pack8(r0, r1), (u32x4*)(RA + off)); __builtin_nontemporal_store(pack8(s0, s1), (u32x4*)(SB + off)); }
}
struct EpiIn {
    static constexpr bool PERM = true, AFTER_DRAIN = false; static constexpr int MID_T = 0;
    unsigned char* ws;
    __device__ __forceinline__ void operator()(const f32x4 (&acc)[2][2][4][2], const Unit& u, int wr, int wc, int fr, int fq) const {
        { const int l_ = lane_id_asm(); fr = l_ & 15; fq = l_ >> 4; }
        const int pn = u.pn, row0 = u.pm * BM + wr * 64 + fr;
        unsigned long long z_ = 0; asm volatile("" : "+s"(z_)); unsigned char* w_ = ws + z_;
        bf16_t *QB = (bf16_t*)(w_ + WSO_QB), *KB = (bf16_t*)(w_ + WSO_KB), *VB = (bf16_t*)(w_ + WSO_VB), *GA = (bf16_t*)(w_ + WSO_GA), *GB = (bf16_t*)(w_ + WSO_GB), *RA = (bf16_t*)(w_ + WSO_RA), *SB = (bf16_t*)(w_ + WSO_SB),
               *CKV = (bf16_t*)(w_ + WSO_CKV), *CQ = (bf16_t*)(w_ + WSO_CQ), *KROPE = (bf16_t*)(w_ + WSO_KROPE);
        float *LOGF = (float*)(w_ + WSO_LOGF), *SSQ_Q = (float*)(w_ + WSO_SSQQ), *SSQ_KV = (float*)(w_ + WSO_SSQKV);
        const float *PAR = (const float*)(w_ + WSO_PAR), *qn_b = PAR + PAR_QNB, *kn_b = PAR + PAR_KNB, *kn_rope = PAR + PAR_KNROPE, *b_f = PAR + PAR_BF, *COS = (const float*)(w_ + WSO_COS), *SIN = (const float*)(w_ + WSO_SIN);
        if (pn < 2) epi_heads<0>(acc, row0, wc, fq, QB, 512, pn * 4, qn_b, C2B, nullptr, 0.f);
        else if (pn < 4) epi_heads<0>(acc, row0, wc, fq, KB, 512, (pn - 2) * 4, kn_b, 1.f, nullptr, 0.f);
        else if (pn < 6) epi_plain<0>(acc, row0, wc, fq, VB, 512, (pn - 4) * 256);
        else if (pn < 8) epi_plain<1>(acc, row0, wc, fq, GA, 512, (pn - 6) * 256);
        else if (pn < 10) epi_plain<1>(acc, row0, wc, fq, GB, 512, (pn - 8) * 256);
        else if (pn < 18) epi_mgates(acc, row0, wc, fq, RA, SB, (pn - 10) * 128);
        else if (pn == 18) { epi_plain<0, false>(acc, row0, wc, fq, CKV, 256, 0); epi_ssq<2>(acc, row0, fq, SSQ_KV, 4, wc); }
        else if (pn == 19) { epi_plain<0, false>(acc, row0, wc, fq, CQ, 384, 0); epi_ssq<2>(acc, row0, fq, SSQ_Q, 8, wc); }
        else {
            epi_ssq<1>(acc, row0, fq, SSQ_Q, 8, 4 + wc);
#pragma unroll
            for (int ai = 0; ai < 2; ++ai)
#pragma unroll
                for (int m = 0; m < 4; ++m) *(u32x4*)(CQ + (size_t)(row0 + ai * HALF + m * 16) * 384 + 256 + wc * 32 + 8 * fq) = pack8(acc[ai][0][m][0], acc[ai][0][m][1]);
            if (wc == 0) {
                const f32x4 w0 = *(const f32x4*)(kn_rope + 8 * fq), w1 = *(const f32x4*)(kn_rope + 8 * fq + 4);
#pragma unroll
                for (int ai = 0; ai < 2; ++ai)
#pragma unroll
                    for (int m = 0; m < 4; ++m) { const size_t row = (size_t)(row0 + ai * HALF + m * 16);
                        rope_group(acc[ai][1][m][0], acc[ai][1][m][1], 1.f, w0, w1, COS + row * 16, SIN + row * 16, fq, 1.f, KROPE + row * 32 + 8 * fq); }
            } else if (wc == 1) {
                if (fq == 0) { const f32x4 b0 = *(const f32x4*)(b_f), b1 = *(const f32x4*)(b_f + 4);
#pragma unroll
                    for (int ai = 0; ai < 2; ++ai)
#pragma unroll
                        for (int m = 0; m < 4; ++m) { const size_t row = (size_t)(row0 + ai * HALF + m * 16); f32x4 z0 = acc[ai][1][m][0] + b0, z1 = acc[ai][1][m][1] + b1;
#pragma unroll
                            for (int e = 0; e < 4; ++e) { z0[e] = fminf(z0[e], 0.f) - log1pf(expf(-fabsf(z0[e]))); z1[e] = fminf(z1[e], 0.f) - log1pf(expf(-fabsf(z1[e]))); }
                            *(f32x4*)(LOGF + row * 8) = z0; *(f32x4*)(LOGF + row * 8 + 4) = z1; } }
            }
        }
    }
};
struct EpiQup {
    static constexpr bool PERM = true, AFTER_DRAIN = false; static constexpr int MID_T = 0;
    unsigned char* ws;
    __device__ __forceinline__ void operator()(const f32x4 (&acc)[2][2][4][2], const Unit& u, int wr, int wc, int fr, int fq) const {
        { const int l_ = lane_id_asm(); fr = l_ & 15; fq = l_ >> 4; }
        const int pn = u.pn, row0 = u.pm * BM + wr * 64 + fr;
        unsigned long long z_ = 0; asm volatile("" : "+s"(z_)); unsigned char* w_ = ws + z_;
        bf16_t *QAN = (bf16_t*)(w_ + WSO_QAN), *QAR = (bf16_t*)(w_ + WSO_QAR);
        const float *SSQ_Q = (const float*)(w_ + WSO_SSQQ), *PAR = (const float*)(w_ + WSO_PAR), *qn_nope = PAR + PAR_QNNOPE, *qn_rope = PAR + PAR_QNROPE, *COS = (const float*)(w_ + WSO_COS), *SIN = (const float*)(w_ + WSO_SIN);
        if (pn < 2) epi_heads<8>(acc, row0, wc, fq, QAN, 512, pn * 4, qn_nope, C2A, SSQ_Q, 1.f / 384.f);
        else { const f32x4 w0 = *(const f32x4*)(qn_rope + 8 * fq), w1 = *(const f32x4*)(qn_rope + 8 * fq + 4);
#pragma unroll
            for (int ai = 0; ai < 2; ++ai)
#pragma unroll
                for (int m = 0; m < 4; ++m) { const size_t row = (size_t)(row0 + ai * HALF + m * 16); const float rsr = row_rs<8>(SSQ_Q, (int)row, 1.f / 384.f);
#pragma unroll
                    for (int bj = 0; bj < 2; ++bj) rope_group(acc[ai][bj][m][0], acc[ai][bj][m][1], rsr, w0, w1, COS + row * 16, SIN + row * 16, fq, C2A, QAR + row * 256 + (4 * bj + wc) * 32 + 8 * fq); } }
    }
};
struct EpiKVup {
    static constexpr bool PERM = true, AFTER_DRAIN = false; static constexpr int MID_T = 0;
    unsigned char* ws;
    __device__ __forceinline__ void operator()(const f32x4 (&acc)[2][2][4][2], const Unit& u, int wr, int wc, int fr, int fq) const {
        { const int l_ = lane_id_asm(); fr = l_ & 15; fq = l_ >> 4; }
        const int pn = u.pn, row0 = u.pm * BM + wr * 64 + fr;
        unsigned long long z_ = 0; asm volatile("" : "+s"(z_)); unsigned char* w_ = ws + z_;
        bf16_t *KAN = (bf16_t*)(w_ + WSO_KAN), *VA = (bf16_t*)(w_ + WSO_VA);
        const float *SSQ_KV = (const float*)(w_ + WSO_SSQKV), *kn_nope = (const float*)(w_ + WSO_PAR) + PAR_KNNOPE;
        if (pn < 2) epi_heads<4>(acc, row0, wc, fq, KAN, 512, pn * 4, kn_nope, 1.f, SSQ_KV, 1.f / 256.f);
        else {
#pragma unroll
            for (int ai = 0; ai < 2; ++ai)
#pragma unroll
                for (int m = 0; m < 4; ++m) { bf16_t* rowp = VA + (size_t)(row0 + ai * HALF + m * 16) * 512 + (pn - 2) * 256 + wc * 32 + 8 * fq; const float r = row_rs<4>(SSQ_KV, row0 + ai * HALF + m * 16, 1.f / 256.f);
#pragma unroll
                    for (int bj = 0; bj < 2; ++bj) __builtin_nontemporal_store(pack8(acc[ai][bj][m][0] * r, acc[ai][bj][m][1] * r), (u32x4*)(rowp + bj * HALF));
                    asm volatile("" ::: "memory"); } }
    }
};
struct EpiMerge {
    static constexpr bool PERM = true, AFTER_DRAIN = false; static constexpr int MID_T = 8;
    unsigned char* ws;
#define EM_LOAD(buf, P, gi) do { const size_t off_ = (size_t)(row0 + ((gi) >> 2) * HALF + ((gi) & 3) * 16) * 1024 + col0; buf[0] = *(const u32x4*)(P + off_); buf[1] = *(const u32x4*)(P + off_ + HALF); } while (0)
#define EM_MUL(v0, v1, s) do { v0[0] *= bf_lo(s.x); v0[1] *= bf_hi(s.x); v0[2] *= bf_lo(s.y); v0[3] *= bf_hi(s.y); v1[0] *= bf_lo(s.z); v1[1] *= bf_hi(s.z); v1[2] *= bf_lo(s.w); v1[3] *= bf_hi(s.w); } while (0)
    __device__ __forceinline__ void mid(f32x4 (&acc)[2][2][4][2], const Unit& u, int wr, int wc, int fr, int fq) const {
        { const int l_ = lane_id_asm(); fr = l_ & 15; fq = l_ >> 4; }
        unsigned long long z_ = 0; asm volatile("" : "+s"(z_)); const bf16_t* RA = (const bf16_t*)(ws + z_ + WSO_RA);
        const int row0 = u.pm * BM + wr * 64 + fr, col0 = u.pn * BM + wc * 32 + 8 * fq;
        u32x4 sa[2], sb[2];
#define EM_MIDAPPLY(buf, gi) do { _Pragma("unroll") for (int bj = 0; bj < 2; ++bj) EM_MUL(acc[(gi) >> 2][bj][(gi) & 3][0], acc[(gi) >> 2][bj][(gi) & 3][1], buf[bj]); } while (0)
        u32x4 sq[8][2];
#pragma unroll
        for (int gi = 0; gi < 8; ++gi) EM_LOAD(sq[gi], RA, gi);
#pragma unroll
        for (int gi = 0; gi < 8; ++gi) EM_MIDAPPLY(sq[gi], gi);
#undef EM_MIDAPPLY
    }
    __device__ __forceinline__ void operator()(const f32x4 (&acc)[2][2][4][2], const Unit& u, int wr, int wc, int fr, int fq) const {
        { const int l_ = lane_id_asm(); fr = l_ & 15; fq = l_ >> 4; }
        unsigned long long z_ = 0; asm volatile("" : "+s"(z_)); unsigned char* w_ = ws + z_; const bf16_t* SB = (const bf16_t*)(w_ + WSO_SB); bf16_t* T = (bf16_t*)(w_ + WSO_MERGED);
        const int row0 = u.pm * BM + wr * 64 + fr, col0 = u.pn * BM + wc * 32 + 8 * fq;
        u32x4 sa[2], sb[2];
#define EM_OUT(buf, gi) do { const size_t off_ = (size_t)(row0 + ((gi) >> 2) * HALF + ((gi) & 3) * 16) * 1024 + col0; \
        _Pragma("unroll") for (int bj = 0; bj < 2; ++bj) { f32x4 v0 = acc[(gi) >> 2][bj][(gi) & 3][0], v1 = acc[(gi) >> 2][bj][(gi) & 3][1]; EM_MUL(v0, v1, buf[bj]); __builtin_nontemporal_store(pack8(v0, v1), (u32x4*)(T + off_ + bj * HALF)); } } while (0)
        u32x4 sq[8][2];
#pragma unroll
        for (int gi = 0; gi < 8; ++gi) EM_LOAD(sq[gi], SB, gi);
#pragma unroll
        for (int gi = 0; gi < 8; ++gi) EM_OUT(sq[gi], gi);
#undef EM_OUT
    }
#undef EM_LOAD
#undef EM_MUL
};
struct PanelOrder {
    int c, G, nN, nM;
    __host__ __device__ void init(int M, int N, int G_, int c_) { nM = M / BM; nN = N / BM; G = G_; c = c_; }
    __host__ __device__ bool next(int i, Unit& u) const { const int pm = c + (i / nN) * G; if (pm >= nM) return false; u.pm = pm; u.pn = i % nN; return true; }
    __device__ __forceinline__ void a_ready(const Unit&) const {}
    __device__ __forceinline__ void done(const Unit&) const {}
};
template <int GS> struct GroupOrder {
    int base, j;
    __host__ __device__ void init(int vcu) { base = (vcu / GS) * GS; j = vcu % GS; }
    __host__ __device__ bool next(int i, Unit& u) const { if (i >= 4) return false; u.pm = base + i * (GS / 4) + (j >> 2); u.pn = j & 3; return true; }
    __device__ __forceinline__ void a_ready(const Unit&) const {}
    __device__ __forceinline__ void done(const Unit&) const {}
};
struct EpiOut {
    static constexpr bool PERM = false, AFTER_DRAIN = false; static constexpr int MID_T = 0;
    const float* X; float* O; const float* GATE;
    __device__ __forceinline__ void operator()(const f32x4 (&acc)[2][2][4][2], const Unit& u, int wr, int wc, int fr, int fq) const {
        { const int l_ = lane_id_asm(); fr = l_ & 15; fq = l_ >> 4; }
        const int row0 = u.pm * BM + wr * 64 + fr, col0 = u.pn * BM + wc * 32 + 4 * fq; const float* g = GATE + (size_t)(u.pm >> 3) * 3072 + col0;
        f32x4 gv[2][2];
#pragma unroll
        for (int bj = 0; bj < 2; ++bj)
#pragma unroll
            for (int n = 0; n < 2; ++n) gv[bj][n] = *(const f32x4*)(g + bj * HALF + n * 16);
        f32x4 xa[2][2], xb[2][2];
#define EO_LOAD(buf, gi) do { const size_t off_ = (size_t)(row0 + ((gi) >> 2) * HALF + ((gi) & 3) * 16) * 1024 + col0; \
        _Pragma("unroll") for (int bj = 0; bj < 2; ++bj) _Pragma("unroll") for (int n = 0; n < 2; ++n) buf[bj][n] = *(const f32x4*)(X + off_ + bj * HALF + n * 16); } while (0)
#define EO_STORE(buf, gi) do { const size_t off_ = (size_t)(row0 + ((gi) >> 2) * HALF + ((gi) & 3) * 16) * 1024 + col0; \
        _Pragma("unroll") for (int bj = 0; bj < 2; ++bj) _Pragma("unroll") for (int n = 0; n < 2; ++n) __builtin_nontemporal_store(buf[bj][n] + gv[bj][n] * acc[(gi) >> 2][bj][(gi) & 3][n], (f32x4*)(O + off_ + bj * HALF + n * 16)); } while (0)
        EO_LOAD(xa, 0);
        EO_LOAD(xb, 1); EO_STORE(xa, 0);
        EO_LOAD(xa, 2); EO_STORE(xb, 1);
        EO_LOAD(xb, 3); EO_STORE(xa, 2);
        EO_LOAD(xa, 4); EO_STORE(xb, 3);
        EO_LOAD(xb, 5); EO_STORE(xa, 4);
        EO_LOAD(xa, 6); EO_STORE(xb, 5);
        EO_LOAD(xb, 7); EO_STORE(xa, 6);
        EO_STORE(xb, 7);
#undef EO_LOAD
#undef EO_STORE
    }
};

template <class Epi, class Sched, bool ALIGN_EPI = false, bool SP2 = false, int UNR = 1>
__device__ __forceinline__ void gemm_phase(PG8_LAS unsigned char* lds, const Gemm g, const Sched& S, const Epi& E, int wave_in  ) {
    const int lane = lane_id_asm(), wid = wave_in, tid = wid * 64 + lane,
        wr = wid >> 2, wc = wid & 3, fr = lane & 15, fq = lane >> 4;
    const int K = g.K, nt = K / BK;
    unsigned voffA[2], voffB[2];
#pragma unroll
    for (int i = 0; i < 2; ++i) { int R, C; stage_rc(tid * 16 + i * 8192, R, C); const int Rb = Epi::PERM ? ((R & ~31) + perm32(R & 31)) : R;
        voffA[i] = (unsigned)(R * K + C) * 2u; voffB[i] = (unsigned)(Rb * K + C) * 2u; }
    const size_t kstep = (size_t)(BK * 2);
    const size_t hstep = (size_t)HALF * K * 2;
    const size_t tstep = 2 * hstep;
    const unsigned ldsw = (unsigned)wid * 1024u;
    const int aoff = lds_byte(wr * 64 + fr, fq * 8), boff = lds_byte(wc * 32 + fr, fq * 8);
#define PG8_SA(b, h) (((b) * 2 + (h)) * HTB)
#define PG8_SB(b, h) ((4 + (b) * 2 + (h)) * HTB)
#define PG8_STAGE(bufoff, gbase, voff) do { _Pragma("unroll") for (int _i = 0; _i < 2; ++_i) \
        __builtin_amdgcn_global_load_lds((const unsigned*)((const char*)(gbase) + (voff)[_i]), (PG8_LAS unsigned*)(lds + (bufoff) + ldsw + _i * 8192), 16, 0, 0); } while (0)
#define PG8_LDA(dst, b, h) do { _Pragma("unroll") for (int m = 0; m < 4; ++m) _Pragma("unroll") for (int k = 0; k < 2; ++k) dst[m][k] = *(const PG8_LAS bf16x8*)(lds + PG8_SA(b, h) + aoff + m * 2048 + k * 1024); } while (0)
#define PG8_LDB(dst, b, h) do { _Pragma("unroll") for (int n = 0; n < 2; ++n) _Pragma("unroll") for (int k = 0; k < 2; ++k) dst[n][k] = *(const PG8_LAS bf16x8*)(lds + PG8_SB(b, h) + boff + n * 2048 + k * 1024); } while (0)
#define PG8_MMA(ai, bj, At, Bt) do { __builtin_amdgcn_s_setprio(1); _Pragma("unroll") for (int m = 0; m < 4; ++m) _Pragma("unroll") for (int n = 0; n < 2; ++n) _Pragma("unroll") for (int k = 0; k < 2; ++k) \
        acc[ai][bj][m][n] = __builtin_amdgcn_mfma_f32_16x16x32_bf16(Bt[n][k], At[m][k], acc[ai][bj][m][n], 0, 0, 0); __builtin_amdgcn_s_setprio(0); } while (0)
#define PG8_WAIT_V(n) asm volatile("s_waitcnt vmcnt(" #n ")" ::: "memory")
#define PG8_WAIT_L(n) asm volatile("s_waitcnt lgkmcnt(" #n ")" ::: "memory")
#define PG8_BAR __builtin_amdgcn_s_barrier()
#define PG8_SCHED __builtin_amdgcn_sched_barrier(0)
    Unit cur, nxt; int ui = 0;
    if (!S.next(0, cur)) return;
    f32x4 acc[2][2][4][2];
#pragma unroll
    for (int a = 0; a < 2; ++a)
#pragma unroll
        for (int b = 0; b < 2; ++b)
#pragma unroll
            for (int m = 0; m < 4; ++m)
#pragma unroll
                for (int n = 0; n < 2; ++n) acc[a][b][m][n] = (f32x4){0.f, 0.f, 0.f, 0.f};
    bf16x8 At[4][2], B0[2][2], B1[2][2];
    const char* cA = (const char*)g.A + (size_t)cur.pm * tstep; const char* cB = (const char*)g.Bt + (size_t)cur.pn * tstep;
    S.a_ready(cur);
    if constexpr (SP2) {
        PG8_STAGE(PG8_SB(0, 0), cB, voffB); PG8_STAGE(PG8_SB(0, 1), cB + hstep, voffB); PG8_STAGE(PG8_SA(0, 0), cA, voffA); PG8_STAGE(PG8_SA(0, 1), cA + hstep, voffA);
        if (wr == 1) PG8_BAR;
        PG8_WAIT_V(2); PG8_BAR;
        PG8_STAGE(PG8_SB(1, 0), cB + kstep, voffB); PG8_STAGE(PG8_SA(1, 0), cA + kstep, voffA); PG8_STAGE(PG8_SB(1, 1), cB + hstep + kstep, voffB);
        PG8_WAIT_V(6); PG8_BAR;
    } else {
        PG8_STAGE(PG8_SB(0, 0), cB, voffB); PG8_STAGE(PG8_SA(0, 0), cA, voffA); PG8_STAGE(PG8_SB(0, 1), cB + hstep, voffB); PG8_STAGE(PG8_SA(0, 1), cA + hstep, voffA);
        if (wr == 1) PG8_BAR;
        PG8_WAIT_V(4); PG8_BAR;
        PG8_STAGE(PG8_SB(1, 0), cB + kstep, voffB); PG8_STAGE(PG8_SA(1, 0), cA + kstep, voffA); PG8_STAGE(PG8_SB(1, 1), cB + hstep + kstep, voffB);
        PG8_WAIT_V(6); PG8_BAR;
    }
    for (;;) {
        const bool has_next = S.next(ui + 1, nxt);
        const char* nA = has_next ? (const char*)g.A + (size_t)nxt.pm * tstep : cA; const char* nB = has_next ? (const char*)g.Bt + (size_t)nxt.pn * tstep : cB;
        _Pragma("clang loop unroll_count(UNR)")
        for (int t = 0; t < nt; t += 2) {
            const bool last = (t == nt - 2);
            const char* a1 = cA + (size_t)(t + 1) * kstep;
            const char* a2 = last ? nA : cA + (size_t)(t + 2) * kstep; const char* b2 = last ? nB : cB + (size_t)(t + 2) * kstep;
            const char* a3 = a2 + kstep; const char* b3 = b2 + kstep;
            if constexpr (Epi::MID_T > 0) { if (t == Epi::MID_T) E.mid(acc, cur, wr, wc, fr, fq); }
            if (last && has_next) S.a_ready(nxt);
            if constexpr (SP2) {
            PG8_LDB(B0, 0, 0); PG8_LDB(B1, 0, 1); PG8_SCHED; PG8_LDA(At, 0, 0); PG8_STAGE(PG8_SA(1, 1), a1 + hstep, voffA);
            PG8_WAIT_V(8); PG8_WAIT_L(0); PG8_BAR; PG8_MMA(0, 0, At, B0); PG8_MMA(0, 1, At, B1); PG8_BAR; PG8_SCHED;
            PG8_LDA(At, 0, 1); PG8_STAGE(PG8_SB(0, 0), b2, voffB); PG8_STAGE(PG8_SB(0, 1), b2 + hstep, voffB); PG8_STAGE(PG8_SA(0, 0), a2, voffA);
            PG8_WAIT_V(8); PG8_WAIT_L(0); PG8_BAR; PG8_MMA(1, 0, At, B0); PG8_MMA(1, 1, At, B1); PG8_BAR; PG8_SCHED;
            PG8_LDB(B0, 1, 0); PG8_LDB(B1, 1, 1); PG8_SCHED; PG8_LDA(At, 1, 0); PG8_STAGE(PG8_SA(0, 1), a2 + hstep, voffA);
            PG8_WAIT_V(8); PG8_WAIT_L(0); PG8_BAR; PG8_MMA(0, 0, At, B0); PG8_MMA(0, 1, At, B1); PG8_BAR; PG8_SCHED;
            PG8_LDA(At, 1, 1); PG8_STAGE(PG8_SB(1, 0), b3, voffB); PG8_STAGE(PG8_SB(1, 1), b3 + hstep, voffB); PG8_STAGE(PG8_SA(1, 0), a3, voffA);
            PG8_WAIT_V(8); PG8_WAIT_L(0); PG8_BAR; PG8_MMA(1, 0, At, B0); PG8_MMA(1, 1, At, B1); PG8_BAR; PG8_SCHED;
            } else {
            PG8_LDB(B0, 0, 0); PG8_SCHED; PG8_LDA(At, 0, 0); PG8_STAGE(PG8_SA(1, 1), a1 + hstep, voffA);
            PG8_WAIT_L(8); PG8_BAR; PG8_WAIT_L(0); PG8_MMA(0, 0, At, B0); PG8_BAR; PG8_SCHED;
            PG8_LDB(B1, 0, 1); PG8_STAGE(PG8_SB(0, 0), b2, voffB);
            PG8_BAR; PG8_WAIT_L(0); PG8_MMA(0, 1, At, B1); PG8_BAR;
            PG8_LDA(At, 0, 1); PG8_STAGE(PG8_SA(0, 0), a2, voffA);
            PG8_BAR; PG8_WAIT_L(0); PG8_MMA(1, 0, At, B0); PG8_BAR; PG8_SCHED;
            PG8_STAGE(PG8_SB(0, 1), b2 + hstep, voffB);
            PG8_WAIT_V(6); PG8_BAR; PG8_MMA(1, 1, At, B1); PG8_BAR;
            PG8_LDB(B0, 1, 0); PG8_SCHED; PG8_LDA(At, 1, 0); PG8_STAGE(PG8_SA(0, 1), a2 + hstep, voffA);
            PG8_WAIT_L(8); PG8_BAR; PG8_WAIT_L(0); PG8_MMA(0, 0, At, B0); PG8_BAR; PG8_SCHED;
            PG8_LDB(B1, 1, 1); PG8_STAGE(PG8_SB(1, 0), b3, voffB);
            PG8_BAR; PG8_WAIT_L(0); PG8_MMA(0, 1, At, B1); PG8_BAR;
            PG8_LDA(At, 1, 1); PG8_STAGE(PG8_SA(1, 0), a3, voffA);
            PG8_BAR; PG8_WAIT_L(0); PG8_MMA(1, 0, At, B0); PG8_BAR; PG8_SCHED;
            PG8_STAGE(PG8_SB(1, 1), b3 + hstep, voffB);
            PG8_WAIT_V(6); PG8_BAR; PG8_MMA(1, 1, At, B1); PG8_BAR;
            }
        }
        if constexpr (ALIGN_EPI) { if (wr == 0) PG8_BAR; }
        if constexpr (!Epi::AFTER_DRAIN) { E(acc, cur, wr, wc, fr, fq); S.done(cur); }
        if (!has_next) break;
#pragma unroll
        for (int a = 0; a < 2; ++a)
#pragma unroll
            for (int b = 0; b < 2; ++b)
#pragma unroll
                for (int m = 0; m < 4; ++m)
#pragma unroll
                    for (int n = 0; n < 2; ++n) acc[a][b][m][n] = (f32x4){0.f, 0.f, 0.f, 0.f};
        cur = nxt; cA = nA; cB = nB; ++ui;
        if constexpr (ALIGN_EPI) { if (wr == 1) PG8_BAR; }
    }
    PG8_WAIT_V(0);
    if constexpr (!ALIGN_EPI) { if (wr == 0) PG8_BAR; }
    PG8_BAR;
    if constexpr (Epi::AFTER_DRAIN) { E.fused(acc, cur, wr, wc, fr, fq, lds, wid, lane); S.done(cur); }
#undef PG8_SA
#undef PG8_SB
#undef PG8_STAGE
#undef PG8_LDA
#undef PG8_LDB
#undef PG8_MMA
#undef PG8_WAIT_V
#undef PG8_WAIT_L
#undef PG8_BAR
#undef PG8_SCHED
}
}
namespace att {
#define LAS3 __attribute__((address_space(3)))
using bf16x8 = __attribute__((ext_vector_type(8))) short;
using s16x4 = __attribute__((ext_vector_type(4))) short;
using f32x16 = __attribute__((ext_vector_type(16))) float;
using f32x4 = __attribute__((ext_vector_type(4))) float;
using u32x4 = __attribute__((ext_vector_type(4))) unsigned;
constexpr int NW = 8, QBLK = 32, QB = 256, KVBLK = 64;
constexpr int LDS_K = 0, LDS_V = 12288, LDS_CUM = 20480, LDS_WS = 28672, LDS_TMP = 30720, LDS_OST = 31744, LDS_BYTES = LDS_OST + NW * 8192;
__device__ __forceinline__ int crow(int r, int hi) { return (r & 3) + 8 * (r >> 2) + 4 * hi; }
typedef float f32x2_t __attribute__((ext_vector_type(2))); typedef __bf16 bf16x2_t __attribute__((ext_vector_type(2)));
__device__ __forceinline__ unsigned cvtpk_s(float lo, float hi) { f32x2_t v = {lo, hi}; bf16x2_t b = __builtin_convertvector(v, bf16x2_t); return __builtin_bit_cast(unsigned, b); }
__device__ __forceinline__ float bf_lo(unsigned u) { return __uint_as_float(u << 16); }
__device__ __forceinline__ float bf_hi(unsigned u) { return __uint_as_float(u & 0xffff0000u); }
#define ATT_SBAR() __builtin_amdgcn_sched_barrier(0)
__device__ __forceinline__ float rowmax(const f32x16& p0, const f32x16& p1) {
    float a = fmaxf(p0[0], p1[0]);
#pragma unroll
    for (int r = 1; r < 16; ++r) a = fmaxf(a, fmaxf(p0[r], p1[r]));
    auto rr = __builtin_amdgcn_permlane32_swap(__float_as_uint(a), __float_as_uint(a), false, false);
    return fmaxf(__uint_as_float(rr[0]), __uint_as_float(rr[1]));
}
__device__ __forceinline__ void pv(f32x16* o, int vb, bf16x8 pa0, bf16x8 pa1, bf16x8 pa2, bf16x8 pa3) {
#pragma unroll
    for (int d0 = 0; d0 < 2; ++d0) { s16x4 lo[4], hi[4];
#pragma unroll
        for (int ks = 0; ks < 4; ++ks) {
            asm volatile("ds_read_b64_tr_b16 %0,%1 offset:%c2" : "=&v"(lo[ks]) : "v"(vb), "i"(d0 * 4096 + ks * 1024) : "memory");
            asm volatile("ds_read_b64_tr_b16 %0,%1 offset:%c2" : "=&v"(hi[ks]) : "v"(vb), "i"(d0 * 4096 + ks * 1024 + 512) : "memory"); }
        asm volatile("s_waitcnt lgkmcnt(0)" ::: "memory"); ATT_SBAR();
#define ATT_PK(k) (bf16x8){lo[k][0], lo[k][1], lo[k][2], lo[k][3], hi[k][0], hi[k][1], hi[k][2], hi[k][3]}
        o[d0] = __builtin_amdgcn_mfma_f32_32x32x16_bf16(pa0, ATT_PK(0), o[d0], 0, 0, 0);
        o[d0] = __builtin_amdgcn_mfma_f32_32x32x16_bf16(pa1, ATT_PK(1), o[d0], 0, 0, 0);
        o[d0] = __builtin_amdgcn_mfma_f32_32x32x16_bf16(pa2, ATT_PK(2), o[d0], 0, 0, 0);
        o[d0] = __builtin_amdgcn_mfma_f32_32x32x16_bf16(pa3, ATT_PK(3), o[d0], 0, 0, 0);
#undef ATT_PK
    }
}
struct Tensors {
    const unsigned short *Q1, *Q2, *K1, *K2, *V, *G; unsigned short* Y; int ypitch;
};
template <bool RAW = false> __device__ __forceinline__ void fox_cum(const float* LOGF, int b, int h, LAS3 float* cum, LAS3 float* tmp8, int wid  ) {
    const int lane = pg8::lane_id_asm(), tid = wid * 64 + lane;
    const float* src = LOGF + ((size_t)b * SEQ + 4 * tid) * 8 + h;
    const float v0 = src[0], v1 = src[8], v2 = src[16], v3 = src[24];
    const float p0 = v0, p1 = p0 + v1, p2 = p1 + v2, p3 = p2 + v3;
    float incl = p3;
#pragma unroll
    for (int off = 1; off < 64; off <<= 1) { const float t = __int_as_float(__builtin_amdgcn_ds_bpermute((lane - off) * 4, __float_as_int(incl))); if (lane >= off) incl += t; }
    if (lane == 63) tmp8[wid] = incl;
    if (RAW) asm volatile("s_waitcnt lgkmcnt(0)\n\ts_barrier" ::: "memory"); else __syncthreads();
    float base = incl - p3;
    for (int w = 0; w < wid; ++w) base += tmp8[w];
    cum[4 * tid + 0] = (base + p0) * LOG2E; cum[4 * tid + 1] = (base + p1) * LOG2E; cum[4 * tid + 2] = (base + p2) * LOG2E; cum[4 * tid + 3] = (base + p3) * LOG2E;
    if (RAW) asm volatile("s_waitcnt lgkmcnt(0)\n\ts_barrier" ::: "memory"); else __syncthreads();
}
template <int MODE> __device__ __forceinline__ void attn_unit(int b, int h, int qb, const Tensors& T, LAS3 unsigned char* lds, int wid  ) {
    constexpr int NQ = MODE ? 6 : 4;
    const int lane = pg8::lane_id_asm(), r32 = lane & 31, hi = lane >> 5;
    const size_t rowbase = (size_t)b * SEQ; const int q0 = qb * QB, NT = (q0 + QB) / KVBLK;
    const int qpos = q0 + wid * QBLK + r32;
    LAS3 float* wsf = (LAS3 float*)(lds + LDS_WS) + wid * 64;
    LAS3 const float* cum = (LAS3 const float*)(lds + LDS_CUM);
    bf16x8 qr[NQ];
#pragma unroll
    for (int d0 = 0; d0 < 4; ++d0) qr[d0] = *(const bf16x8*)(T.Q1 + (rowbase + qpos) * 512 + h * 64 + d0 * 16 + hi * 8);
    if (MODE) {
#pragma unroll
        for (int d0 = 0; d0 < 2; ++d0) qr[4 + d0] = *(const bf16x8*)(T.Q2 + (rowbase + qpos) * 256 + h * 32 + d0 * 16 + hi * 8); }
    float m_run = -INFINITY, l_run = 0.f; f32x16 o[2]; o[0] = f32x16{}; o[1] = f32x16{};
    const float cq = MODE ? 0.f : cum[qpos];
    const int vb0 = (int)(unsigned)(uintptr_t)(lds + LDS_V) + ((lane >> 4) & 1) * 32 + (lane & 3) * 8 + (4 * hi + ((lane & 15) >> 2)) * 64;
    for (int t = 0; t < NT; ++t) {
        __syncthreads();
        { const size_t krow = rowbase + (size_t)t * KVBLK;
          const u32x4 kv = *(const u32x4*)(T.K1 + (krow + lane) * 512 + h * 64 + wid * 8);
          const u32x4 vv = *(const u32x4*)(T.V + (krow + 16 * (wid & 3) + (lane >> 2)) * 512 + h * 64 + (wid >> 2) * 32 + (lane & 3) * 8);
          *(LAS3 u32x4*)(lds + LDS_K + wid * 1024 + lane * 16) = kv;
          *(LAS3 u32x4*)(lds + LDS_V + wid * 1024 + lane * 16) = vv;
          if (MODE && wid < 4) { const u32x4 k2 = *(const u32x4*)(T.K2 + (krow + lane) * 32 + wid * 8); *(LAS3 u32x4*)(lds + LDS_K + (8 + wid) * 1024 + lane * 16) = k2; } }
        __syncthreads();
        f32x16 p0 = f32x16{}, p1 = f32x16{};
#pragma unroll
        for (int d0 = 0; d0 < NQ; ++d0) {
            const bf16x8 b0 = *(LAS3 const bf16x8*)(lds + LDS_K + (2 * d0 + hi) * 1024 + r32 * 16);
            const bf16x8 b1 = *(LAS3 const bf16x8*)(lds + LDS_K + (2 * d0 + hi) * 1024 + 512 + r32 * 16);
            p0 = __builtin_amdgcn_mfma_f32_32x32x16_bf16(b0, qr[d0], p0, 0, 0, 0); p1 = __builtin_amdgcn_mfma_f32_32x32x16_bf16(b1, qr[d0], p1, 0, 0, 0); }
        if (MODE == 0) {
            const int kb = t * KVBLK + 4 * hi;
#pragma unroll
            for (int g = 0; g < 4; ++g) { const f32x4 c0 = *(LAS3 const f32x4*)(cum + kb + 8 * g), c1 = *(LAS3 const f32x4*)(cum + kb + 32 + 8 * g);
#pragma unroll
                for (int e = 0; e < 4; ++e) { const int kv = kb + 8 * g + e;
                    p0[4 * g + e] = (kv > qpos) ? -INFINITY : p0[4 * g + e] + (cq - c0[e]);
                    p1[4 * g + e] = (kv + 32 > qpos) ? -INFINITY : p1[4 * g + e] + (cq - c1[e]); } }
        } else {
            if (t > (qpos >> 6)) {
#pragma unroll
                for (int r = 0; r < 16; ++r) { p0[r] = -INFINITY; p1[r] = -INFINITY; } }
        }
        const float rm = rowmax(p0, p1), m_new = fmaxf(m_run, rm), alpha = __builtin_amdgcn_exp2f(m_run - m_new);
        float sum = 0.f;
#pragma unroll
        for (int r = 0; r < 16; ++r) { p0[r] = __builtin_amdgcn_exp2f(p0[r] - m_new); p1[r] = __builtin_amdgcn_exp2f(p1[r] - m_new); sum += p0[r] + p1[r]; }
        l_run = l_run * alpha + sum; m_run = m_new;
        if (hi == 0) wsf[r32] = alpha;
        asm volatile("s_waitcnt lgkmcnt(0)" ::: "memory");
#pragma unroll
        for (int d = 0; d < 2; ++d)
#pragma unroll
            for (int r = 0; r < 16; ++r) o[d][r] *= wsf[crow(r, hi)];
        asm volatile("s_waitcnt lgkmcnt(0)" ::: "memory");
        u32x4 pw0, pw1, pw2, pw3;
        pw0 = (u32x4){cvtpk_s(p0[0], p0[1]), cvtpk_s(p0[2], p0[3]), cvtpk_s(p0[4], p0[5]), cvtpk_s(p0[6], p0[7])};
        pw1 = (u32x4){cvtpk_s(p0[8], p0[9]), cvtpk_s(p0[10], p0[11]), cvtpk_s(p0[12], p0[13]), cvtpk_s(p0[14], p0[15])};
        pw2 = (u32x4){cvtpk_s(p1[0], p1[1]), cvtpk_s(p1[2], p1[3]), cvtpk_s(p1[4], p1[5]), cvtpk_s(p1[6], p1[7])};
        pw3 = (u32x4){cvtpk_s(p1[8], p1[9]), cvtpk_s(p1[10], p1[11]), cvtpk_s(p1[12], p1[13]), cvtpk_s(p1[14], p1[15])};
        ATT_SBAR();
        pv(o, vb0, __builtin_bit_cast(bf16x8, pw0), __builtin_bit_cast(bf16x8, pw1), __builtin_bit_cast(bf16x8, pw2), __builtin_bit_cast(bf16x8, pw3));
    }
    { auto rr = __builtin_amdgcn_permlane32_swap(__float_as_uint(l_run), __float_as_uint(l_run), false, false); l_run = __uint_as_float(rr[0]) + __uint_as_float(rr[1]); }
    if (hi == 0) wsf[32 + r32] = l_run;
    asm volatile("s_waitcnt lgkmcnt(0)" ::: "memory");
    LAS3 float* stg = (LAS3 float*)(lds + LDS_OST + wid * 8192);
#pragma unroll
    for (int r = 0; r < 16; ++r) { const int orow = crow(r, hi); const float rl = __builtin_amdgcn_rcpf(wsf[32 + orow]);
#pragma unroll
        for (int d0 = 0; d0 < 2; ++d0) stg[orow * 64 + d0 * 32 + r32] = o[d0][r] * rl; }
    asm volatile("s_waitcnt lgkmcnt(0)" ::: "memory");
#pragma unroll
    for (int i = 0; i < 4; ++i) { const int row = i * 8 + (lane >> 3), ch = lane & 7;
        const f32x4 a0 = *(LAS3 const f32x4*)(stg + row * 64 + ch * 8), a1 = *(LAS3 const f32x4*)(stg + row * 64 + ch * 8 + 4);
        const size_t gi = (rowbase + q0 + wid * QBLK + row) * 512 + h * 64 + ch * 8;
        const u32x4 g = *(const u32x4*)(T.G + gi);
        u32x4 w; w.x = cvtpk_s(a0[0] * bf_lo(g.x), a0[1] * bf_hi(g.x)); w.y = cvtpk_s(a0[2] * bf_lo(g.y), a0[3] * bf_hi(g.y));
        w.z = cvtpk_s(a1[0] * bf_lo(g.z), a1[1] * bf_hi(g.z)); w.w = cvtpk_s(a1[2] * bf_lo(g.w), a1[3] * bf_hi(g.w));
        *(u32x4*)(T.Y + (rowbase + q0 + wid * QBLK + row) * (size_t)T.ypitch + h * 64 + ch * 8) = w; }
    asm volatile("s_waitcnt lgkmcnt(0)" ::: "memory");
}
#undef ATT_SBAR
}

namespace attp {
#define LAS3 __attribute__((address_space(3)))
using bf16x8 = __attribute__((ext_vector_type(8))) short;
using s16x4 = __attribute__((ext_vector_type(4))) short;
using f32x16 = __attribute__((ext_vector_type(16))) float;
using f32x4 = __attribute__((ext_vector_type(4))) float;
using u32x4 = __attribute__((ext_vector_type(4))) unsigned;
constexpr int NW = 8, QBLK = 32, QB = 256, KVBLK = 64;
constexpr int KSLOTB = 12288, VSLOTB = 8192, NSLOT = 3;
constexpr int LDS_K = 0, LDS_V = NSLOT * KSLOTB, LDS_WS = LDS_V + NSLOT * VSLOTB, LDS_CUM = LDS_WS + NW * 256  , LDS_TMP = LDS_CUM + 16384, LDS_OST = LDS_TMP + 1024, LDS_BYTES = LDS_OST + NW * 4096;
__device__ __forceinline__ int crow(int r, int hi) { return (r & 3) + 8 * (r >> 2) + 4 * hi; }
typedef float f32x2_t __attribute__((ext_vector_type(2))); typedef __bf16 bf16x2_t __attribute__((ext_vector_type(2)));
__device__ __forceinline__ unsigned cvtpk_s(float lo, float hi) { f32x2_t v = {lo, hi}; bf16x2_t b = __builtin_convertvector(v, bf16x2_t); return __builtin_bit_cast(unsigned, b); }
__device__ __forceinline__ float bf_lo(unsigned u) { return __uint_as_float(u << 16); }
__device__ __forceinline__ float bf_hi(unsigned u) { return __uint_as_float(u & 0xffff0000u); }
__device__ __forceinline__ void glds16(const void* gsrc, unsigned lds_dst) { unsigned keep;
    asm volatile("s_mov_b32 %0, m0\n\ts_mov_b32 m0, %2\n\ts_nop 0\n\tglobal_load_lds_dwordx4 %1, off\n\ts_mov_b32 m0, %0" : "=&s"(keep) : "v"(gsrc), "s"(lds_dst) : "memory"); }
typedef LAS3 const char* lds_cptr;
typedef short v4i16_t __attribute__((ext_vector_type(4)));
typedef int v4i32_t __attribute__((ext_vector_type(4)));
__device__ __forceinline__ void kload2(bf16x8* kf, lds_cptr kp, int j) { kf[2 * j] = *(LAS3 const bf16x8*)(kp + j * 2048); kf[2 * j + 1] = *(LAS3 const bf16x8*)(kp + j * 2048 + 512); }
__device__ __forceinline__ s16x4 vtr(lds_cptr p) { return __builtin_bit_cast(s16x4, __builtin_amdgcn_ds_read_tr16_b64_v4i16((LAS3 v4i16_t*)p)); }
#define AP_SBAR() __builtin_amdgcn_sched_barrier(0)
#define AP_WAIT_BAR(N) asm volatile("s_waitcnt vmcnt(" #N ") lgkmcnt(0)\n\ts_barrier" ::: "memory")
#define AP_MX3(a, b, c) __builtin_fmaxf(__builtin_fmaxf((a), (b)), (c))
__device__ __forceinline__ float rowmax(const f32x16& p0, const f32x16& p1) {
    float a = AP_MX3(p0[0], p0[1], p1[0]), b = AP_MX3(p0[2], p0[3], p1[1]); a = AP_MX3(a, p1[2], p1[3]);
#pragma unroll
    for (int r = 4; r < 16; r += 4) { a = AP_MX3(a, p0[r], p0[r + 1]); b = AP_MX3(b, p0[r + 2], p0[r + 3]); a = AP_MX3(a, p1[r], p1[r + 1]); b = AP_MX3(b, p1[r + 2], p1[r + 3]); }
    float m = __builtin_fmaxf(a, b); auto rr = __builtin_amdgcn_permlane32_swap(__float_as_uint(m), __float_as_uint(m), false, false);
    return __builtin_fmaxf(__uint_as_float(rr[0]), __uint_as_float(rr[1]));
}
__device__ __forceinline__ void pv(f32x16* o, int vb, bf16x8 pa0, bf16x8 pa1, bf16x8 pa2, bf16x8 pa3) {
#pragma unroll
    for (int d0 = 0; d0 < 2; ++d0) { s16x4 lo[4], hi[4];
#pragma unroll
        for (int ks = 0; ks < 4; ++ks) {
            asm volatile("ds_read_b64_tr_b16 %0,%1 offset:%c2" : "=&v"(lo[ks]) : "v"(vb), "i"(d0 * 4096 + ks * 1024) : "memory");
            asm volatile("ds_read_b64_tr_b16 %0,%1 offset:%c2" : "=&v"(hi[ks]) : "v"(vb), "i"(d0 * 4096 + ks * 1024 + 512) : "memory"); }
        asm volatile("s_waitcnt lgkmcnt(0)" ::: "memory"); AP_SBAR();
#define AP_PK(k) (bf16x8){lo[k][0], lo[k][1], lo[k][2], lo[k][3], hi[k][0], hi[k][1], hi[k][2], hi[k][3]}
        o[d0] = __builtin_amdgcn_mfma_f32_32x32x16_bf16(pa0, AP_PK(0), o[d0], 0, 0, 0);
        o[d0] = __builtin_amdgcn_mfma_f32_32x32x16_bf16(pa1, AP_PK(1), o[d0], 0, 0, 0);
        o[d0] = __builtin_amdgcn_mfma_f32_32x32x16_bf16(pa2, AP_PK(2), o[d0], 0, 0, 0);
        o[d0] = __builtin_amdgcn_mfma_f32_32x32x16_bf16(pa3, AP_PK(3), o[d0], 0, 0, 0);
#undef AP_PK
    }
}
struct Tensors {
    const unsigned short *Q1, *Q2, *K1, *K2, *V, *G; unsigned short* Y; int ypitch;
};
__device__ __forceinline__ void cmask(f32x16& p0, f32x16& p1, int jb, int qrel, int hi) {
    int d = qrel - (64 * jb + 4 * hi); asm volatile("" : "+v"(d));
#pragma unroll
    for (int r = 0; r < 16; ++r) { const int c = (r & 3) + 8 * (r >> 2); if (c > d) p0[r] = -INFINITY; if (c + 32 > d) p1[r] = -INFINITY; }
}
__device__ __forceinline__ void chmask(f32x16& p0, f32x16& p1, int jb, int wchunk) {
    if (jb > wchunk) {
#pragma unroll
        for (int r = 0; r < 16; ++r) { p0[r] = -INFINITY; p1[r] = -INFINITY; } }
}

__device__ __forceinline__ int fox_t0(LAS3 const float* cum, int q0, int ntf, float thr) {
    const int lane = pg8::lane_id_asm();
    const float c0 = cum[q0], ck = cum[(lane < ntf ? lane : ntf - 1) * KVBLK + KVBLK - 1];
    const bool need = (lane < ntf) && !(c0 - ck < -thr);
    const unsigned long long m = __ballot(need);
    int t = m ? (int)__builtin_ctzll(m) : 0;
    t &= ~1; if (t > ntf - 4) t = ntf - 4; if (t < 0) t = 0;
    return __builtin_amdgcn_readfirstlane(t);
}
template <int MODE, int THRL, bool FIXREF, bool EARLY> __device__ __forceinline__ int attn_unit(int b, int h, int qb, const Tensors& T, LAS3 unsigned char* lds, int wid  , float bnd,
                                                                                 int s0, bool pre, int nmode, const unsigned char* wsn, int bn, int hn, int qbn, bf16x8 (&qx)[6], int t0, int t0n, int cumsel) {
    constexpr int NQ = MODE ? 6 : 4, NKF = 2 * NQ;
    const int lane = pg8::lane_id_asm(), r32 = lane & 31, hi = lane >> 5;
    const size_t rowbase = (size_t)b * SEQ; const int q0 = qb * QB;
    const unsigned lds0 = (unsigned)(uintptr_t)lds;
    LAS3 float* wsf = (LAS3 float*)(lds + LDS_WS) + wid * 64;
    LAS3 const float* cum = (LAS3 const float*)(lds + LDS_CUM + cumsel * 8192);
    const unsigned short* ksrc = T.K1 + (rowbase + (size_t)t0 * KVBLK + lane) * 512 + h * 64 + wid * 8;
    const unsigned short* k2src = MODE ? T.K2 + (rowbase + (size_t)t0 * KVBLK + lane) * 32 + (wid & 3) * 8 : nullptr;
    const unsigned short* vsrc = T.V + (rowbase + (size_t)t0 * KVBLK + 16 * (wid & 3) + (lane >> 2)) * 512 + h * 64 + (wid >> 2) * 32 + (lane & 3) * 8;
    const unsigned kdst = lds0 + LDS_K + wid * 1024, k2dst = lds0 + LDS_K + (8 + (wid & 3)) * 1024, vdst = lds0 + LDS_V + wid * 1024;
#define DMA_K(t, si) do { glds16(ksrc + (size_t)(t) * KVBLK * 512, (unsigned)__builtin_amdgcn_readfirstlane(kdst + (si) * KSLOTB)); \
        if (MODE) glds16(k2src + (size_t)(t) * KVBLK * 32, (unsigned)__builtin_amdgcn_readfirstlane(k2dst + (si) * KSLOTB)); } while (0)
#define DMA_V(t, si) glds16(vsrc + (size_t)(t) * KVBLK * 512, (unsigned)__builtin_amdgcn_readfirstlane(vdst + (si) * VSLOTB))
    const int vb0 = (int)(lds0 + LDS_V) + ((lane >> 4) & 1) * 32 + (lane & 3) * 8 + (4 * hi + ((lane & 15) >> 2)) * 64;
    const lds_cptr lds3 = (lds_cptr)lds; const lds_cptr kp0 = lds3 + LDS_K + hi * 1024 + r32 * 16;
    const lds_cptr vp0 = lds3 + LDS_V + ((lane >> 4) & 1) * 32 + (lane & 3) * 8 + (4 * hi + ((lane & 15) >> 2)) * 64;
    bf16x8 kf[NKF];
    const int NT = (q0 + QB) / KVBLK - t0;
    LAS3 const float* cumt = cum + t0 * KVBLK;
    const int NTc = NT - (EARLY ? 2 : 0);
    const int s1 = (s0 == NSLOT - 1) ? 0 : s0 + 1, s2 = (s1 == NSLOT - 1) ? 0 : s1 + 1;
    if (!pre) { DMA_K(0, s0); DMA_V(0, s0); DMA_K(1, s1); }
    bf16x8 qr[NQ];
    constexpr bool QPF = FIXREF;
    if (pre && QPF) {
#pragma unroll
        for (int d0 = 0; d0 < NQ; ++d0) qr[d0] = qx[d0];
    } else { const size_t qrow = rowbase + q0 + wid * QBLK + r32;
#pragma unroll
      for (int d0 = 0; d0 < 4; ++d0) qr[d0] = *(const bf16x8*)(T.Q1 + qrow * 512 + h * 64 + d0 * 16 + hi * 8);
      if (MODE) {
#pragma unroll
          for (int d0 = 0; d0 < 2; ++d0) qr[4 + d0] = *(const bf16x8*)(T.Q2 + qrow * 256 + h * 32 + d0 * 16 + hi * 8); }
      if (QPF) { asm volatile("s_waitcnt vmcnt(0)" ::: "memory");
#pragma unroll
          for (int d0 = 0; d0 < NQ; ++d0) asm volatile("" : "+v"(qr[d0])); } }
    static_assert(FIXREF, "the row sums ride on the MFMA pipe (ones operand): only the reference-free units are instantiated");
    float mhat = 0.f; f32x16 o[2], lacc;
    bf16x8 ones; { int w_ = 0x3F803F80; asm volatile("" : "+v"(w_)); const v4i32_t t_ = {w_, w_, w_, w_}; ones = __builtin_bit_cast(bf16x8, t_); }
    { float z_ = 0.f; asm volatile("" : "+v"(z_));
#pragma unroll
      for (int r = 0; r < 16; ++r) lacc[r] = z_; }
    { float z_ = 0.f; asm volatile("" : "+v"(z_));
#pragma unroll
      for (int r = 0; r < 16; ++r) { o[0][r] = z_; o[1][r] = z_; } }
    const int qrel = wid * QBLK + r32, wchunk = wid >> 1;
    const float cq = MODE ? 0.f : cum[q0 + qrel];
    float base = cq;
    (void)bnd;
    bool resc = false;
#define CMASK(P0, P1, t) do { int jb_ = (t) - (NT - 4); if (MODE ? (jb_ >= 0) : (jb_ >= wchunk)) {        if (MODE) chmask(P0, P1, jb_, wchunk); else cmask(P0, P1, jb_, qrel, hi); } } while (0)
#define PREFILL4(X0, X1, tt, G) do { if (MODE) { if ((G) < 4) { X0[4 * (G)] = base; X0[4 * (G) + 1] = base; X0[4 * (G) + 2] = base; X0[4 * (G) + 3] = base; } \
                                               else { X1[4 * ((G) - 4)] = base; X1[4 * ((G) - 4) + 1] = base; X1[4 * ((G) - 4) + 2] = base; X1[4 * ((G) - 4) + 3] = base; } } \
        else { const f32x4 c_ = *(LAS3 const f32x4*)(cumt + (tt) * KVBLK + 4 * hi + 8 * ((G) & 3) + 32 * ((G) >> 2)); \
               if ((G) < 4) { X0[4 * (G)] = base - c_[0]; X0[4 * (G) + 1] = base - c_[1]; X0[4 * (G) + 2] = base - c_[2]; X0[4 * (G) + 3] = base - c_[3]; } \
               else { X1[4 * ((G) - 4)] = base - c_[0]; X1[4 * ((G) - 4) + 1] = base - c_[1]; X1[4 * ((G) - 4) + 2] = base - c_[2]; X1[4 * ((G) - 4) + 3] = base - c_[3]; } } } while (0)
#define CRD(cv, tt, G) do { cv = *(LAS3 const f32x4*)(cumt + (tt) * KVBLK + 4 * hi + 8 * ((G) & 3) + 32 * ((G) >> 2)); } while (0)
#define FSUB(d, a, b) do { asm("v_sub_f32 %0, %1, %2" : "=v"(d) : "v"(a), "v"(b)); } while (0)
#define PREFILL4U(X0, X1, cv, G) do { if ((G) < 4) { FSUB(X0[4 * (G)], base, cv[0]); FSUB(X0[4 * (G) + 1], base, cv[1]); FSUB(X0[4 * (G) + 2], base, cv[2]); FSUB(X0[4 * (G) + 3], base, cv[3]); } \
               else { FSUB(X1[4 * ((G) - 4)], base, cv[0]); FSUB(X1[4 * ((G) - 4) + 1], base, cv[1]); FSUB(X1[4 * ((G) - 4) + 2], base, cv[2]); FSUB(X1[4 * ((G) - 4) + 3], base, cv[3]); } } while (0)
#define PREFILL_ALL(X0, X1, tt) do { PREFILL4(X0, X1, tt, 0); PREFILL4(X0, X1, tt, 1); PREFILL4(X0, X1, tt, 2); PREFILL4(X0, X1, tt, 3); PREFILL4(X0, X1, tt, 4); PREFILL4(X0, X1, tt, 5); PREFILL4(X0, X1, tt, 6); PREFILL4(X0, X1, tt, 7); \
        asm volatile("" : "+v"(X0), "+v"(X1)); } while (0)
#define RESC() do { if (resc) { asm volatile("s_waitcnt lgkmcnt(0)" ::: "memory"); \
      _Pragma("unroll") for (int d_ = 0; d_ < 2; ++d_) _Pragma("unroll") for (int r = 0; r < 16; ++r) o[d_][r] *= wsf[crow(r, hi)]; } } while (0)
    f32x16 pA0, pA1, pB0, pB1;
    int si_prev = s0, si_cur = s0, si_next = s1;
#define ROT() do { si_prev = si_cur; si_cur = si_next; si_next = (si_next == NSLOT - 1) ? 0 : si_next + 1; } while (0)
    if (!pre) DMA_K(2, s2);
    if (!MODE) PREFILL_ALL(pA0, pA1, 0);
    if (pre && QPF) AP_WAIT_BAR(4);
    else if (MODE) AP_WAIT_BAR(5); else AP_WAIT_BAR(3);
    {
#pragma unroll
        for (int j = 0; j < NQ; ++j) kload2(kf, kp0 + s0 * KSLOTB, j);
#pragma unroll
        for (int d0 = 0; d0 < NQ; ++d0) { if (MODE && d0 == 0) { float z_ = 0.f; asm volatile("" : "+v"(z_)); _Pragma("unroll") for (int r = 0; r < 16; ++r) { pA0[r] = z_; pA1[r] = z_; } }
            pA0 = __builtin_amdgcn_mfma_f32_32x32x16_bf16(kf[2 * d0], qr[d0], pA0, 0, 0, 0); pA1 = __builtin_amdgcn_mfma_f32_32x32x16_bf16(kf[2 * d0 + 1], qr[d0], pA1, 0, 0, 0); }
        CMASK(pA0, pA1, 0);
        if (FIXREF) {
#pragma unroll
            for (int r = 0; r < 16; ++r) pA0[r] = __builtin_amdgcn_exp2f(pA0[r]);
        } else {
        const float rm = rowmax(pA0, pA1); mhat = rm; base = cq - mhat;
#pragma unroll
        for (int r = 0; r < 16; ++r) { pA0[r] = __builtin_amdgcn_exp2f(pA0[r] - rm); pA1[r] = __builtin_amdgcn_exp2f(pA1[r] - rm); } }
    }
    if (!MODE) PREFILL_ALL(pB0, pB1, 1);
    if (pre && QPF) AP_WAIT_BAR(4); else AP_WAIT_BAR(0);
    DMA_K(3, s0); DMA_V(1, s1);
    ROT();
#pragma unroll
    for (int j = 0; j < NQ; ++j) kload2(kf, kp0 + si_cur * KSLOTB, j);
    if (MODE) AP_WAIT_BAR(3); else AP_WAIT_BAR(2);
    s16x4 vlo[8], vhi[8]; u32x4 pw0, pw1, pw2, pw3;
#define PKW(P, B) cvtpk_s(P[B], P[B + 1])
#define PAF(k) __builtin_bit_cast(bf16x8, pw##k)
#define VFR(i) (bf16x8){vlo[i][0], vlo[i][1], vlo[i][2], vlo[i][3], vhi[i][0], vhi[i][1], vhi[i][2], vhi[i][3]}
#define PIN(x) asm volatile("" : "+v"(x))
#define FADD(a, b) do { asm("v_add_f32 %0, %0, %1" : "+v"(a) : "v"(b)); } while (0)
#define GAPA(MF, EXV, EXB, W0, W1, PW) do { MF; if ((EXB) >= 0) { EXV[(EXB) & 15] = EX(EXV[(EXB) & 15]); EXV[((EXB) + 1) & 15] = EX(EXV[((EXB) + 1) & 15]); EXV[((EXB) + 2) & 15] = EX(EXV[((EXB) + 2) & 15]); EXV[((EXB) + 3) & 15] = EX(EXV[((EXB) + 3) & 15]); PIN(EXV); } W0; W1; PIN(PW); AP_SBAR(); } while (0)
#define LMF(k) do { lacc = __builtin_amdgcn_mfma_f32_32x32x16_bf16(PAF(k), ones, lacc, 0, 0, 0); } while (0)
#define EX(v) __builtin_amdgcn_exp2f((MODE && !FIXREF) ? (v) + base : (v))
#define GAPB(MF, X, B, GP, Y0, Y1, tt, G, CUR, NXT) do { MF; X[B] = EX(X[B]); X[B + 1] = EX(X[B + 1]); PIN(X);        if ((GP) && !MODE) { PREFILL4U(Y0, Y1, ca_, G); if ((G) < 4) PIN(Y0); else PIN(Y1); if ((G) < 7) CRD(ca_, tt, (G) + 1); } AP_SBAR(); } while (0)
#define VRD(i) do { vlo[i] = vtr(vp_ + (((i) >> 2) * 4096 + ((i) & 3) * 1024)); vhi[i] = vtr(vp_ + (((i) >> 2) * 4096 + ((i) & 3) * 1024 + 512)); } while (0)
#define KRD(Gf, j) do { if (Gf) { kload2(kf, kp0 + si_next * KSLOTB, j); AP_SBAR(); } } while (0)
#define MF(Cx, kidx, qidx) Cx = __builtin_amdgcn_mfma_f32_32x32x16_bf16(kf[kidx], qr[qidx], Cx, 0, 0, 0)
#define MF0(Cx, kidx, qidx) do { if (MODE) Cx = __builtin_amdgcn_mfma_f32_32x32x16_bf16(kf[kidx], qr[qidx], (f32x16){0.f, 0.f, 0.f, 0.f, 0.f, 0.f, 0.f, 0.f, 0.f, 0.f, 0.f, 0.f, 0.f, 0.f, 0.f, 0.f}, 0, 0, 0); else MF(Cx, kidx, qidx); } while (0)
#define STEP(C0, C1, P0, P1, t, GK, GV, GL, GP, QN) do { AP_SBAR(); \
    const lds_cptr vp_ = vp0 + si_prev * VSLOTB; \
    VRD(0); AP_SBAR(); \
    GAPA(MF0(C0, 0, 0), P1, 0,  pw0[0] = PKW(P0, 0), pw0[1] = PKW(P0, 2), pw0); \
    VRD(4); AP_SBAR(); GAPA(MF0(C1, 1, 0), P1, 4,  pw0[2] = PKW(P0, 4), pw0[3] = PKW(P0, 6), pw0); \
    VRD(1); AP_SBAR(); GAPA(MF(C0, 2, 1),   P1, 8,  pw1[0] = PKW(P0, 8), pw1[1] = PKW(P0, 10), pw1); \
    VRD(5); AP_SBAR(); GAPA(MF(C1, 3, 1),   P1, 12, pw1[2] = PKW(P0, 12), pw1[3] = PKW(P0, 14), pw1); \
    VRD(2); AP_SBAR(); GAPA(MF(C0, 4, 2),   P1, -1, pw2[0] = PKW(P1, 0), pw2[1] = PKW(P1, 2), pw2); \
    VRD(6); AP_SBAR(); GAPA(MF(C1, 5, 2),   P1, -1, pw2[2] = PKW(P1, 4), pw2[3] = PKW(P1, 6), pw2); \
    VRD(3); AP_SBAR(); GAPA(MF(C0, 6, 3),   P1, -1, pw3[0] = PKW(P1, 8), pw3[1] = PKW(P1, 10), pw3); \
    VRD(7); AP_SBAR(); GAPA(MF(C1, 7, 3),   P1, -1, pw3[2] = PKW(P1, 12), pw3[3] = PKW(P1, 14), pw3); \
    if (MODE) { MF(C0, 8, 4); MF(C1, 9, 4); MF(C0, 10, 5); MF(C1, 11, 5); AP_SBAR(); } \
    f32x4 ca_; if ((GP) && !MODE) CRD(ca_, (t) + 1, 0); \
    if (GK) { DMA_K((t) + 3, si_cur); } if (GV) { DMA_V((t) + 1, si_next); } \
    CMASK(C0, C1, t); \
    if (!FIXREF) { float a = AP_MX3(C0[0], C0[1], C1[0]), b_ = AP_MX3(C0[2], C0[3], C1[1]); a = AP_MX3(a, C1[2], C1[3]); \
      _Pragma("unroll") for (int r = 4; r < 16; r += 4) { a = AP_MX3(a, C0[r], C0[r + 1]); b_ = AP_MX3(b_, C0[r + 2], C0[r + 3]); a = AP_MX3(a, C1[r], C1[r + 1]); b_ = AP_MX3(b_, C1[r + 2], C1[r + 3]); } \
      float rm = __builtin_fmaxf(a, b_); { auto rr = __builtin_amdgcn_permlane32_swap(__float_as_uint(rm), __float_as_uint(rm), false, false); rm = __builtin_fmaxf(__uint_as_float(rr[0]), __uint_as_float(rr[1])); } \
      resc = false; if (MODE) rm += base; \
      if (__builtin_expect(__any(rm > (float)THRL), 0)) { const float dl = __builtin_fmaxf(rm, 0.f); mhat += dl; base = cq - mhat; \
        if (!MODE) { _Pragma("unroll") for (int r = 0; r < 16; ++r) { C0[r] -= dl; C1[r] -= dl; } } \
        const float f = __builtin_amdgcn_exp2f(-dl); if (hi == 0) wsf[r32] = f; resc = true; } } \
    AP_SBAR(); if (QN) { QNLOAD(); AP_SBAR(); }        \
    GAPB(o[0] = __builtin_amdgcn_mfma_f32_32x32x16_bf16(PAF(0), VFR(0), o[0], 0, 0, 0); LMF(0), C0, 0, GP, P0, P1, (t) + 1, 0, ca_, cb_); \
    if (MODE) KRD(GL, 0); \
    GAPB(o[1] = __builtin_amdgcn_mfma_f32_32x32x16_bf16(PAF(0), VFR(4), o[1], 0, 0, 0), C0, 2, GP, P0, P1, (t) + 1, 1, cb_, ca_); \
    KRD(GL, MODE ? 1 : 0); GAPB(o[0] = __builtin_amdgcn_mfma_f32_32x32x16_bf16(PAF(1), VFR(1), o[0], 0, 0, 0); LMF(1), C0, 4, GP, P0, P1, (t) + 1, 2, ca_, cb_); \
    KRD(GL, MODE ? 2 : 1); GAPB(o[1] = __builtin_amdgcn_mfma_f32_32x32x16_bf16(PAF(1), VFR(5), o[1], 0, 0, 0), C0, 6, GP, P0, P1, (t) + 1, 3, cb_, ca_); \
    KRD(GL, MODE ? 3 : 2); GAPB(o[0] = __builtin_amdgcn_mfma_f32_32x32x16_bf16(PAF(2), VFR(2), o[0], 0, 0, 0); LMF(2), C0, 8, GP, P0, P1, (t) + 1, 4, ca_, cb_); \
    KRD(GL, MODE ? 4 : 3); GAPB(o[1] = __builtin_amdgcn_mfma_f32_32x32x16_bf16(PAF(2), VFR(6), o[1], 0, 0, 0), C0, 10, GP, P0, P1, (t) + 1, 5, cb_, ca_); \
    if (MODE) KRD(GL, 5); \
    GAPB(o[0] = __builtin_amdgcn_mfma_f32_32x32x16_bf16(PAF(3), VFR(3), o[0], 0, 0, 0); LMF(3), C0, 12, GP, P0, P1, (t) + 1, 6, ca_, cb_); \
    GAPB(o[1] = __builtin_amdgcn_mfma_f32_32x32x16_bf16(PAF(3), VFR(7), o[1], 0, 0, 0), C0, 14, GP, P0, P1, (t) + 1, 7, cb_, ca_); \
    } while (0)
#define STEADY_WAIT() do { if (MODE) AP_WAIT_BAR(3); else AP_WAIT_BAR(2); } while (0)
    u32x4 gq[4];
#define QNLOAD() do { const int ln_ = pg8::lane_id_asm(); \
        _Pragma("unroll") for (int d0 = 0; d0 < 6; ++d0) asm volatile("" : "=v"(qx[d0]));        \
        if (nmode >= 0) { const size_t qrow_ = (size_t)bn * SEQ + qbn * QB + wid * QBLK + (ln_ & 31); \
            const unsigned short* q1_ = (const unsigned short*)(wsn + (nmode ? WSO_QAN : WSO_QB)) + qrow_ * 512 + hn * 64 + (ln_ >> 5) * 8; \
            _Pragma("unroll") for (int d0 = 0; d0 < 4; ++d0) qx[d0] = *(const bf16x8*)(q1_ + d0 * 16); \
            if (nmode) { const unsigned short* q2_ = (const unsigned short*)(wsn + WSO_QAR) + qrow_ * 256 + hn * 32 + (ln_ >> 5) * 8; \
                _Pragma("unroll") for (int d0 = 0; d0 < 2; ++d0) qx[4 + d0] = *(const bf16x8*)(q2_ + d0 * 16); } } \
        _Pragma("unroll") for (int i = 0; i < 4; ++i) gq[i] = *(const u32x4*)(T.G + (rowbase + q0 + wid * QBLK + i * 8 + (ln_ >> 3)) * 512 + h * 64 + (ln_ & 7) * 8); } while (0)
    int t = 1;
#undef CMASK
#define CMASK(P0, P1, t) do { } while (0)
    for (; t + 5 < NTc; t += 2) {
        STEP(pB0, pB1, pA0, pA1, t, true, true, true, true, false);       STEADY_WAIT(); RESC(); ROT();
        STEP(pA0, pA1, pB0, pB1, t + 1, true, true, true, true, false);   STEADY_WAIT(); RESC(); ROT();
    }
#undef CMASK
#define CMASK(P0, P1, t) do { int jb_ = (t) - (NT - 4); if (MODE ? (jb_ >= 0) : (jb_ >= wchunk)) {        if (MODE) chmask(P0, P1, jb_, wchunk); else cmask(P0, P1, jb_, qrel, hi); } } while (0)
#define ENDW(tt) do { if ((tt) + 3 < NT) { STEADY_WAIT(); } else if ((tt) + 2 < NT) { AP_WAIT_BAR(1); } else { AP_WAIT_BAR(0); } } while (0)
    for (; t + 1 < NTc; t += 2) {
        STEP(pB0, pB1, pA0, pA1, t, (t + 3 < NT), (t + 1 < NT), (t + 1 < NTc), (t + 1 < NTc), false);           ENDW(t);     RESC(); ROT();
        STEP(pA0, pA1, pB0, pB1, t + 1, (t + 4 < NT), (t + 2 < NT), (t + 2 < NTc), (t + 2 < NTc), false);       ENDW(t + 1); RESC(); ROT();
    }
#define DRAIN(sl_) do { \
      _Pragma("unroll") for (int r = 0; r < 16; ++r) pB1[r] = EX(pB1[r]); \
      pw0 = (u32x4){PKW(pB0, 0), PKW(pB0, 2), PKW(pB0, 4), PKW(pB0, 6)}; pw1 = (u32x4){PKW(pB0, 8), PKW(pB0, 10), PKW(pB0, 12), PKW(pB0, 14)}; \
      pw2 = (u32x4){PKW(pB1, 0), PKW(pB1, 2), PKW(pB1, 4), PKW(pB1, 6)}; pw3 = (u32x4){PKW(pB1, 8), PKW(pB1, 10), PKW(pB1, 12), PKW(pB1, 14)}; \
      AP_SBAR(); LMF(0); LMF(1); LMF(2); LMF(3); pv(o, vb0 + (sl_) * VSLOTB, PAF(0), PAF(1), PAF(2), PAF(3)); } while (0)
    if (EARLY) {
        STEP(pB0, pB1, pA0, pA1, NTc - 1, false, true, false, false, false);
        const int sd = si_cur;
        ENDW(NTc - 1); ROT();
        DMA_V(NT - 1, si_next);
        if ((wid >> 1) == 1) DRAIN(sd);
        ENDW(NT - 2); ROT();
    }
    int sret = 0;
    if (nmode >= 0) {
        const int n0 = si_next, n1 = (n0 == NSLOT - 1) ? 0 : n0 + 1, n2 = (n1 == NSLOT - 1) ? 0 : n1 + 1; sret = n0;
        const size_t nrow = (size_t)bn * SEQ + (size_t)t0n * KVBLK; const int ln_ = pg8::lane_id_asm();
        const unsigned short* nk = (const unsigned short*)(wsn + (nmode ? WSO_KAN : WSO_KB)) + (nrow + ln_) * 512 + hn * 64 + wid * 8;
        const unsigned short* nk2 = (const unsigned short*)(wsn + WSO_KROPE) + (nrow + ln_) * 32 + (wid & 3) * 8;
        const unsigned short* nv = (const unsigned short*)(wsn + (nmode ? WSO_VA : WSO_VB)) + (nrow + 16 * (wid & 3) + (ln_ >> 2)) * 512 + hn * 64 + (wid >> 2) * 32 + (ln_ & 3) * 8;
#define NDMA_K(t, si) do { glds16(nk + (size_t)(t) * KVBLK * 512, (unsigned)__builtin_amdgcn_readfirstlane(kdst + (si) * KSLOTB)); \
        if (nmode) glds16(nk2 + (size_t)(t) * KVBLK * 32, (unsigned)__builtin_amdgcn_readfirstlane(k2dst + (si) * KSLOTB)); } while (0)
        NDMA_K(0, n0); glds16(nv, (unsigned)__builtin_amdgcn_readfirstlane(vdst + n0 * VSLOTB)); NDMA_K(1, n1); NDMA_K(2, n2);
#undef NDMA_K
    }
    if (EARLY) { QNLOAD(); }
    else { STEP(pB0, pB1, pA0, pA1, NT - 1, false, false, false, false, QPF); RESC(); }
#undef QNLOAD
    if (!QPF) {
#pragma unroll
        for (int i = 0; i < 4; ++i) gq[i] = *(const u32x4*)(T.G + (rowbase + q0 + wid * QBLK + i * 8 + (lane >> 3)) * 512 + h * 64 + (lane & 7) * 8); }
    if (!EARLY) { if ((wid >> 1) == 3) DRAIN(si_cur); }
#undef DRAIN
    { LAS3 unsigned short* stg = (LAS3 unsigned short*)(lds + LDS_OST) + wid * 2048;
#pragma unroll
      for (int r = 0; r < 16; r += 1) { const int orow = crow(r, hi); const float rl = __builtin_amdgcn_rcpf(lacc[r]);
#pragma unroll
          for (int d0 = 0; d0 < 2; ++d0) stg[orow * 64 + d0 * 32 + r32] = (unsigned short)(cvtpk_s(o[d0][r] * rl, 0.f) & 0xffffu); }
      asm volatile("s_waitcnt lgkmcnt(0)" ::: "memory");
      if (QPF) {
#pragma unroll
          for (int d0 = 0; d0 < 6; ++d0) asm volatile("" : "+v"(qx[d0])); }
#pragma unroll
      for (int i = 0; i < 4; ++i) { const int row = i * 8 + (lane >> 3), ch = lane & 7; const u32x4 v = *(LAS3 const u32x4*)(stg + row * 64 + ch * 8);
          const u32x4 g = gq[i];
          u32x4 w; w.x = cvtpk_s(bf_lo(v.x) * bf_lo(g.x), bf_hi(v.x) * bf_hi(g.x)); w.y = cvtpk_s(bf_lo(v.y) * bf_lo(g.y), bf_hi(v.y) * bf_hi(g.y));
          w.z = cvtpk_s(bf_lo(v.z) * bf_lo(g.z), bf_hi(v.z) * bf_hi(g.z)); w.w = cvtpk_s(bf_lo(v.w) * bf_lo(g.w), bf_hi(v.w) * bf_hi(g.w));
          __builtin_nontemporal_store(w, (u32x4*)(T.Y + (rowbase + q0 + wid * QBLK + row) * (size_t)T.ypitch + h * 64 + ch * 8)); } }
    if (!QPF) {
#pragma unroll
        for (int d0 = 0; d0 < 6; ++d0) asm volatile("" : "=v"(qx[d0])); }
    asm volatile("s_waitcnt lgkmcnt(0)\n\ts_barrier" ::: "memory");
    return sret;
#undef DMA_K
#undef DMA_V
#undef CMASK
#undef PREFILL4
#undef PREFILL4U
#undef CRD
#undef PREFILL_ALL
#undef RESC
#undef ROT
#undef PKW
#undef PAF
#undef VFR
#undef PIN
#undef GAPA
#undef LMF
#undef FADD
#undef FSUB
#undef GAPB
#undef EX
#undef VRD
#undef KRD
#undef MF
#undef MF0
#undef STEP
#undef STEADY_WAIT
#undef ENDW
}
#undef AP_SBAR
#undef AP_WAIT_BAR
#undef AP_MX3
}

constexpr int NWAVES = 8;
#ifndef MK_N_LAUNCHES
#define MK_N_LAUNCHES 1
#endif
constexpr int N_PHASES = 7;
constexpr int N_LAUNCHES = MK_N_LAUNCHES;
static_assert(N_LAUNCHES == 1 || N_LAUNCHES == N_PHASES, "MK_N_LAUNCHES is 1 or 7");

constexpr int CW_BAR = 4096;

constexpr int RING_OFF = 0, RING_BYTES = 131072;
constexpr int LDSCTL_OFF = RING_BYTES, MISC_OFF = LDSCTL_OFF + 320;
constexpr int LDS_BYTES = 147456;
static_assert(att::LDS_BYTES <= RING_BYTES && attp::LDS_BYTES <= RING_BYTES, "attention scratch fits the ring region");

#define GAS __attribute__((address_space(1)))
#define LAS __attribute__((address_space(3)))
typedef unsigned short bf16;
typedef unsigned v4u __attribute__((ext_vector_type(4)));
typedef float f32x4 __attribute__((ext_vector_type(4)));
typedef short bf16x8 __attribute__((ext_vector_type(8)));
typedef GAS unsigned gu32;
typedef GAS unsigned long long gu64;
#define RLX_AGENT __ATOMIC_RELAXED, __HIP_MEMORY_SCOPE_AGENT
#define LDS_WAIT() asm volatile("s_waitcnt lgkmcnt(0)" ::: "memory")
#define VM_WAIT() asm volatile("s_waitcnt vmcnt(0)" ::: "memory")
__device__ __forceinline__ unsigned long long rt() { return __builtin_amdgcn_s_memrealtime(); }
__device__ __forceinline__ unsigned f2bf(float f) { unsigned u = __builtin_bit_cast(unsigned, f); return (u + 0x7fffu + ((u >> 16) & 1u)) >> 16; }
__device__ __forceinline__ unsigned pk2(float lo, float hi) { return f2bf(lo) | (f2bf(hi) << 16); }

#define XB_TMO      128
#define XB_XCNT(j)  (256  + 64 * (j))
#define XB_XSUB(j)  (1280 + 64 * (j))
#define XB_XGEN(j)  (2304 + 64 * (j))
#define XB_TOP      3328
#define XB_TOPGEN   3392
#define XCD_BAR_WORDS 3456
#define XB_SPIN_CAP (1u << 18)

__device__ __forceinline__ unsigned xb_ld(unsigned* p)              { return __hip_atomic_load(p, __ATOMIC_RELAXED, __HIP_MEMORY_SCOPE_AGENT); }
__device__ __forceinline__ unsigned xb_add(unsigned* p, unsigned v) { return __hip_atomic_fetch_add(p, v, __ATOMIC_RELAXED, __HIP_MEMORY_SCOPE_AGENT); }
__device__ __forceinline__ unsigned xb_xcc_id() { return (unsigned)__builtin_amdgcn_s_getreg((3 << 11) | 20) & 0xFu; }
#define XB_SPIN(cond, bar) do { unsigned _sp = 0; while (cond) { __builtin_amdgcn_s_sleep(1); \
    if ((++_sp & 255u) == 0u) { if (xb_ld(&(bar)[XB_TMO])) break; if (_sp > XB_SPIN_CAP) { atomicAdd(&(bar)[XB_TMO], 1u); break; } } } } while (0)

struct XcdBarrier {
    unsigned* bar; unsigned x;
    volatile LAS unsigned* st;
};

__device__ __forceinline__ XcdBarrier xcd_barrier_post(unsigned* bar, volatile LAS unsigned* st) {
    XcdBarrier b; b.bar = bar; b.x = xb_xcc_id(); b.st = st;
    if (threadIdx.x == 0) (void)xb_add(&bar[XB_XCNT(b.x)], 1u);
    return b;
}
__device__ __forceinline__ void xcd_barrier_complete(unsigned* bar, unsigned x, unsigned& nloc, unsigned& nx) {
    const unsigned G = gridDim.x * gridDim.y * gridDim.z;
    unsigned sum, cnt, mine, sp = 0u;
    for (;;) {
        sum = 0u; cnt = 0u; mine = 0u;
#pragma unroll
        for (unsigned j = 0; j < 16; ++j) { const unsigned c = xb_ld(&bar[XB_XCNT(j)]); sum += c; cnt += (c > 0u) ? 1u : 0u; mine = (j == x) ? c : mine; }
        if (sum == G) break;
        __builtin_amdgcn_s_sleep(1);
        if ((++sp & 255u) == 0u) { if (xb_ld(&bar[XB_TMO])) break; if (sp > XB_SPIN_CAP) { atomicAdd(&bar[XB_TMO], 1u); break; } }
    }
    nloc = mine > 0u ? mine : 1u; nx = cnt > 0u ? cnt : 1u;
}

__device__ __forceinline__ void xcd_barrier(const XcdBarrier& b) {
    asm volatile("s_waitcnt vmcnt(0)" ::: "memory");
    __syncthreads();
    if (threadIdx.x == 0) {
        unsigned* bar = b.bar;
        __builtin_amdgcn_s_waitcnt(0);
        unsigned nloc = b.st[0], nx = b.st[1];
        if (nloc == 0u) { xcd_barrier_complete(bar, b.x, nloc, nx); b.st[0] = nloc; b.st[1] = nx; }
        const unsigned old = xb_add(&bar[XB_XSUB(b.x)], 1u);
        const unsigned gen = old / nloc;
        if (old + 1u == (gen + 1u) * nloc) {
            __builtin_amdgcn_fence(__ATOMIC_RELEASE, "agent");
            asm volatile("s_waitcnt vmcnt(0)" ::: "memory");
            const unsigned og = xb_add(&bar[XB_TOP], 1u);
            const unsigned tg = og / nx;
            if (og + 1u == (tg + 1u) * nx) xb_add(&bar[XB_TOPGEN], 1u);
            else XB_SPIN(xb_ld(&bar[XB_TOPGEN]) == tg, bar);
            __builtin_amdgcn_fence(__ATOMIC_ACQUIRE, "agent");
            xb_add(&bar[XB_XGEN(b.x)], 1u);
            asm volatile("s_waitcnt vmcnt(0)" ::: "memory");
        } else {
            XB_SPIN(xb_ld(&bar[XB_XGEN(b.x)]) == gen, bar);
            __builtin_amdgcn_fence(__ATOMIC_ACQUIRE, "agent");
            asm volatile("s_waitcnt vmcnt(0)" ::: "memory");
        }
    }
    __syncthreads();
}

template <int GS> __device__ __forceinline__ void group_barrier(unsigned* ctl, unsigned* bar, int vcu) {
    asm volatile("s_waitcnt vmcnt(0)" ::: "memory");
    __syncthreads();
    if (threadIdx.x == 0) {
        unsigned* w = ctl + 64 * (vcu / GS);
        __builtin_amdgcn_s_waitcnt(0);
        const unsigned id0 = xb_ld(&w[1]); bool same = (id0 != 0u);
#pragma unroll
        for (int m = 1; m < GS; ++m) same = same && (xb_ld(&w[1 + m]) == id0);
        if (!same) { __builtin_amdgcn_fence(__ATOMIC_RELEASE, "agent"); asm volatile("s_waitcnt vmcnt(0)" ::: "memory"); }
        (void)xb_add(&w[0], 1u);
        XB_SPIN(xb_ld(&w[0]) < (unsigned)GS, bar);
        __builtin_amdgcn_fence(__ATOMIC_ACQUIRE, "agent");
        asm volatile("s_waitcnt vmcnt(0)" ::: "memory");
    }
    __syncthreads();
}

struct Frame {
    LAS unsigned char* lds;
    int wave;
    int vcu, G;
};
__device__ const float INVF[16] = {1.000000000e+00f, 5.623413324e-01f, 3.162277639e-01f, 1.778279394e-01f, 1.000000015e-01f, 5.623413250e-02f, 3.162277490e-02f, 1.778279431e-02f,
                                   9.999999776e-03f, 5.623413250e-03f, 3.162277630e-03f, 1.778279431e-03f, 1.000000047e-03f, 5.623413017e-04f, 3.162277571e-04f, 1.778279402e-04f};

__device__ __forceinline__ void p0_transpose_item(const float* W, int K, int Nsrc, int src_col0, int nvalid, const float* kscale, bf16* WT, int dst_row0, LAS float* scr, int kb, int lane, int dk0 = -1) {
    const int k0 = 64 * kb, c = lane & 31; if (dk0 < 0) dk0 = k0;
    (void)c;
#pragma unroll 8
    for (int i = 0; i < 8; ++i) { const int kk = 8 * i + (lane >> 3), c4 = lane & 7; f32x4 v = (f32x4){0.f, 0.f, 0.f, 0.f};
        if (4 * c4 < nvalid) v = *(const f32x4*)(W + (size_t)(k0 + kk) * Nsrc + src_col0 + 4 * c4);
        if (kscale) v *= kscale[k0 + kk];
        scr[kk * 33 + 4 * c4] = v[0]; scr[kk * 33 + 4 * c4 + 1] = v[1]; scr[kk * 33 + 4 * c4 + 2] = v[2]; scr[kk * 33 + 4 * c4 + 3] = v[3]; }
    LDS_WAIT(); asm volatile("" ::: "memory");
    const int ch = lane & 7;
#pragma unroll
    for (int j = 0; j < 4; ++j) { const int n = (lane >> 3) + 8 * j; const LAS float* s = scr + (8 * ch) * 33 + n;
        v4u o; o.x = pk2(s[0 * 33], s[1 * 33]); o.y = pk2(s[2 * 33], s[3 * 33]); o.z = pk2(s[4 * 33], s[5 * 33]); o.w = pk2(s[6 * 33], s[7 * 33]);
        *(GAS v4u*)(WT + (size_t)(dst_row0 + n) * K + dk0 + 8 * ch) = o; }
    LDS_WAIT(); asm volatile("" ::: "memory");
}
__device__ __forceinline__ void win_block_src(int nb, int& src, int& nvalid) {
    const int tile = nb >> 3, blk = nb & 7, bj = blk >> 2, wc = blk & 3; nvalid = 32;
    if (tile < 2) src = OC_QB + tile * 256 + 64 * wc + 32 * bj;
    else if (tile < 4) src = OC_KB + (tile - 2) * 256 + 64 * wc + 32 * bj;
    else if (tile < 6) src = OC_VB + (tile - 4) * 256 + 32 * blk;
    else if (tile < 8) src = OC_GA + (tile - 6) * 256 + 32 * blk;
    else if (tile < 10) src = OC_GB + (tile - 8) * 256 + 32 * blk;
    else if (tile < 18) src = (bj ? OC_MB : OC_MA) + (tile - 10) * 128 + 32 * wc;
    else if (tile == 18) src = OC_CKV + 32 * blk;
    else if (tile == 19) src = OC_CQ + 32 * blk;
    else { if (blk < 4) src = OC_CQ + 256 + 32 * blk; else if (blk == 4) src = OC_KR; else if (blk == 5) { src = OC_FB; nvalid = 8; } else { src = 0; nvalid = 0; } }
}
struct Args { const float* in[21]; float* out; unsigned char* ws; int ph_lo, ph_hi, li, pad; };

__device__ __forceinline__ float wave_sum(float v) {
#pragma unroll
    for (int o = 1; o < 64; o <<= 1) v += __shfl_xor(v, o);
    return v;
}

__device__ __forceinline__ void p0_prologue(Frame& F, const Args& a) {
    unsigned char* ws = a.ws; const int lane = pg8::lane_id_asm(), tid = F.wave * 64 + lane;
    LAS float* scr = (LAS float*)(F.lds + RING_OFF + F.wave * 16384);
    const int gw = F.vcu * NWAVES + F.wave, NGW = F.G * NWAVES;
    const float *w_in = a.in[6], *w_uq = a.in[10], *w_ukv = a.in[11], *w_a = a.in[18], *w_b = a.in[19], *w_out = a.in[20];
    bf16 *Win_t = (bf16*)(ws + WSO_WIN), *Wuq_t = (bf16*)(ws + WSO_WUQ), *Wukv_t = (bf16*)(ws + WSO_WUKV), *Wcat_t = (bf16*)(ws + WSO_WCAT), *Wout_t = (bf16*)(ws + WSO_WOUT);
    constexpr int I_IN = 16 * 168, I_UQ = 6 * 24, I_UKV = 4 * 32, I_A = 8 * 32, I_B = 8 * 32, I_OUT = 16 * 32;
    constexpr int NITEMS = I_IN + I_UQ + I_UKV + I_A + I_B + I_OUT;
    for (int it = gw; it < NITEMS; it += NGW) {
        int r = it;
        if (r < I_IN) { const int kb = r / 168, nb = r % 168; int src, nv; win_block_src(nb, src, nv); p0_transpose_item(w_in, 1024, DIN, src, nv, nullptr, Win_t, nb * 32, scr, kb, lane); continue; } r -= I_IN;
        if (r < I_UQ) { const int kb = r / 24, nb = r % 24, tile = nb >> 3, blk = nb & 7, bj = blk >> 2, wc = blk & 3;
            const int src = (tile < 2) ? (4 * tile + wc) * 96 + 32 * bj : (4 * bj + wc) * 96 + 64;
            p0_transpose_item(w_uq, 384, 768, src, 32, a.in[8], Wuq_t, nb * 32, scr, kb, lane); continue; } r -= I_UQ;
        if (r < I_UKV) { const int kb = r / 32, nb = r % 32, tile = nb >> 3, blk = nb & 7, bj = blk >> 2, wc = blk & 3;
            const int src = (tile < 2) ? (4 * tile + wc) * 128 + 32 * bj : (4 * (tile - 2) + (blk >> 1)) * 128 + 64 + 32 * (blk & 1);
            p0_transpose_item(w_ukv, 256, 1024, src, 32, a.in[9], Wukv_t, nb * 32, scr, kb, lane); continue; } r -= I_UKV;
        if (r < I_A) { p0_transpose_item(w_a, 1024, 1024, (r % 32) * 32, 32, nullptr, Wcat_t, (r % 32) * 32, scr, r / 32, lane, 64 * (r / 32)); continue; } r -= I_A;
        if (r < I_B) { p0_transpose_item(w_b, 1024, 1024, (r % 32) * 32, 32, nullptr, Wcat_t, (r % 32) * 32, scr, r / 32, lane, 512 + 64 * (r / 32)); continue; } r -= I_B;
        p0_transpose_item(w_out, 1024, 1024, (r % 32) * 32, 32, nullptr, Wout_t, (r % 32) * 32, scr, r / 32, lane);
    }
    if (gw == 0) { float* PAR = (float*)(ws + WSO_PAR); const int l = lane;
        PAR[PAR_QNB + l] = a.in[16][l]; PAR[PAR_KNB + l] = a.in[17][l]; PAR[PAR_QNNOPE + l] = a.in[12][l]; PAR[PAR_KNNOPE + l] = a.in[14][l];
        if (l < 32) { PAR[PAR_KNROPE + l] = a.in[15][l]; PAR[PAR_QNROPE + l] = a.in[13][l]; }
        if (l < 8) PAR[PAR_BF + l] = a.in[7][l];
        float mqb = fabsf(a.in[16][l]), mkb = fabsf(a.in[17][l]), mqn = fabsf(a.in[12][l]), mkn = fabsf(a.in[14][l]), mqr = fabsf(a.in[13][l & 31]), mkr = fabsf(a.in[15][l & 31]);
#pragma unroll
        for (int o = 1; o < 64; o <<= 1) { mqb = fmaxf(mqb, __shfl_xor(mqb, o)); mkb = fmaxf(mkb, __shfl_xor(mkb, o)); mqn = fmaxf(mqn, __shfl_xor(mqn, o)); mkn = fmaxf(mkn, __shfl_xor(mkn, o)); mqr = fmaxf(mqr, __shfl_xor(mqr, o)); mkr = fmaxf(mkr, __shfl_xor(mkr, o)); }
        if (l == 0) { PAR[PAR_BNDB] = 64.f * mqb * mkb * C2B * 1.02f; PAR[PAR_BNDA] = (64.f * mqn * mkn + 32.f * mqr * mkr) * C2A * 1.02f; } }
    { const int* pos = (const int*)a.in[2]; float* COS = (float*)(ws + WSO_COS); float* SIN = (float*)(ws + WSO_SIN);
      const int gt = F.vcu * (NWAVES * 64) + tid, NGT = F.G * NWAVES * 64;
      for (int e = gt; e < MTOK * 16; e += NGT) { const float ang = (float)pos[e >> 4] * INVF[e & 15]; COS[e] = cosf(ang); SIN[e] = sinf(ang); } }
}
__device__ __forceinline__ void p0_ada(Frame& F, const Args& a) {
    const int lane = pg8::lane_id_asm(), tid = F.wave * 64 + lane, cg = lane & 15, kq = lane >> 4;
    const float *c = a.in[1], *w_ada = a.in[3], *b_ada = a.in[4]; float* ADA = (float*)(a.ws + WSO_ADA);
    LAS float* part = (LAS float*)(F.lds + RING_OFF);
    LAS float* cs = (LAS float*)(F.lds + RING_OFF + 65536);
    for (int item = F.vcu; item < 256; item += F.G) { const int cb = item % 64, bg = item / 64, k0 = 128 * F.wave;
        __syncthreads();
        for (int e = tid; e < 8 * 1024; e += NWAVES * 64) { const int bb = e >> 10, k = e & 1023; cs[k * 8 + bb] = c[(size_t)(8 * bg + bb) * 1024 + k]; }
        __syncthreads();
        const float* wp = w_ada + (size_t)(k0 + kq) * 3072 + 48 * cb + 4 * (cg < 12 ? cg : 0);
        f32x4 acc[8];
#pragma unroll
        for (int i = 0; i < 8; ++i) acc[i] = (f32x4){0.f, 0.f, 0.f, 0.f};
#pragma unroll 4
        for (int i = 0; i < 32; ++i) { const f32x4 wv = *(const f32x4*)(wp + (size_t)(4 * i) * 3072);
            const f32x4 c0 = *(const LAS f32x4*)(cs + (k0 + 4 * i + kq) * 8), c1 = *(const LAS f32x4*)(cs + (k0 + 4 * i + kq) * 8 + 4);
#pragma unroll
            for (int bb = 0; bb < 4; ++bb) { acc[bb] += wv * c0[bb]; acc[4 + bb] += wv * c1[bb]; } }
#pragma unroll
        for (int bb = 0; bb < 8; ++bb) if (cg < 12) *(LAS f32x4*)(part + ((F.wave * 4 + kq) * 8 + bb) * 64 + 4 * cg) = acc[bb];
        __syncthreads();
        { const int i = tid >> 6, l = tid & 63; float s = 0.f;
#pragma unroll
          for (int w = 0; w < 32; ++w) s += part[(w * 8 + i) * 64 + l];
          if (l < 48) ADA[(size_t)(8 * bg + i) * 3072 + 48 * cb + l] = s + b_ada[48 * cb + l]; }
    }
    __syncthreads();
}
__device__ __forceinline__ unsigned xn_swap1(unsigned v) { const int x_ = (int)v; return (unsigned)__builtin_amdgcn_update_dpp(x_, x_, 0xB1, 0xf, 0xf, false); }
__device__ __forceinline__ void p1_xn(Frame& F, const Args& a) {
    const int lane = pg8::lane_id_asm(); const bool odd = (lane & 1) != 0;
    const float *x = a.in[0], *nw = a.in[5]; const float* ADA = (const float*)(a.ws + WSO_ADA); bf16* XN = (bf16*)(a.ws + WSO_XN);
    const int gw = F.vcu * NWAVES + F.wave, NGW = F.G * NWAVES;
    for (int chunk = gw; chunk < MTOK / 32; chunk += NGW) { const int m0 = chunk * 32; const float* ad = ADA + (size_t)(m0 >> 11) * 3072;
        f32x4 g[4], sh[4];
#pragma unroll
        for (int j = 0; j < 4; ++j) { const int col = 4 * lane + 256 * j; g[j] = *(const f32x4*)(nw + col) * (*(const f32x4*)(ad + 1024 + col) + 1.0f); sh[j] = *(const f32x4*)(ad + col); }
        f32x4 va[4], vb[4];
#define XN_LOAD(buf, mm) do { const GAS f32x4* xr_ = (const GAS f32x4*)(x + (size_t)(mm) * DMODEL) + lane; _Pragma("unroll") for (int j = 0; j < 4; ++j) buf[j] = __builtin_nontemporal_load(xr_ + 64 * j); } while (0)
#define XN_ROW(buf, mm, nxt_ok, nxt_m) do { const int m = (mm); \
            f32x4 v[4]; float s = 0.f; \
            _Pragma("unroll") for (int j = 0; j < 4; ++j) { v[j] = buf[j]; s += (v[j].x * v[j].x + v[j].y * v[j].y) + (v[j].z * v[j].z + v[j].w * v[j].w); } \
            if (nxt_ok) XN_LOAD(buf, nxt_m); \
            const float rstd = rsqrtf(wave_sum(s) * (1.f / DMODEL) + EPS); \
            unsigned plo[4], phi[4]; \
            _Pragma("unroll") for (int j = 0; j < 4; ++j) { const f32x4 h = v[j] * rstd * g[j] + sh[j]; plo[j] = pg8::cvt_pk_bf16(h.x, h.y); phi[j] = pg8::cvt_pk_bf16(h.z, h.w); } \
            bf16* orow = XN + (size_t)m * DMODEL + 4 * (lane & ~1); \
            _Pragma("unroll") for (int jp = 0; jp < 2; ++jp) { const int j0 = 2 * jp, j1 = 2 * jp + 1; \
                const unsigned r0_ = xn_swap1(odd ? plo[j0] : plo[j1]), r1_ = xn_swap1(odd ? phi[j0] : phi[j1]);        \
                v4u o; if (odd) { o.x = r0_; o.y = r1_; o.z = plo[j1]; o.w = phi[j1]; } else { o.x = plo[j0]; o.y = phi[j0]; o.z = r0_; o.w = r1_; } \
                *(GAS v4u*)(orow + 256 * (odd ? j1 : j0)) = o; } } while (0)
        f32x4 vc[4], vd[4];
        XN_LOAD(va, m0); XN_LOAD(vb, m0 + 1); XN_LOAD(vc, m0 + 2); XN_LOAD(vd, m0 + 3);
#pragma unroll 1
        for (int r = 0; r < 32; r += 4) {
            XN_ROW(va, m0 + r, r + 4 < 32, m0 + r + 4);
            XN_ROW(vb, m0 + r + 1, r + 5 < 32, m0 + r + 5);
            XN_ROW(vc, m0 + r + 2, r + 6 < 32, m0 + r + 6);
            XN_ROW(vd, m0 + r + 3, r + 7 < 32, m0 + r + 7);
        }
#undef XN_LOAD
#undef XN_ROW
    }
}

#ifndef ATT_FIXREF
#define ATT_FIXREF true
#endif
#ifndef P2_WGM
#define P2_WGM 4
#endif
#ifndef MLA_PIPE
#define MLA_PIPE 1
#endif
#ifndef PROBE_FORCE_FALLBACK
#define PROBE_FORCE_FALLBACK 0
#endif
#ifndef P56_GS
#define P56_GS 4
#endif
#ifndef PROBE_REPEAT
#define PROBE_REPEAT 0
#endif
#define P4_REPS (((PROBE_REPEAT >> 4) & 1) ? 2 : 1)
template <bool EARLY> __device__ __forceinline__ void p4_fast(const Frame& F, unsigned char* wsp, float bndb, float bnda, bool shared4, int nrounds) {
    typedef pg8::bf16_t hb;
#define WSP(off) (wsp + (off))
        if (!EARLY) __builtin_amdgcn_s_setprio(1);
        LAS unsigned char* al = F.lds + RING_OFF; const float* LOGF = (const float*)WSP(WSO_LOGF);
        hb *QB = (hb*)WSP(WSO_QB), *KB = (hb*)WSP(WSO_KB), *VB = (hb*)WSP(WSO_VB), *GB = (hb*)WSP(WSO_GB), *GA = (hb*)WSP(WSO_GA), *QAN = (hb*)WSP(WSO_QAN), *QAR = (hb*)WSP(WSO_QAR), *KAN = (hb*)WSP(WSO_KAN), *KROPE = (hb*)WSP(WSO_KROPE), *VA = (hb*)WSP(WSO_VA), *YCAT = (hb*)WSP(WSO_YCAT);
        LAS int* hperm = (LAS int*)(F.lds + MISC_OFF) + 16; LAS const int* jmtab = (LAS const int*)(F.lds + MISC_OFF) + 40;
        attp::bf16x8 qx[6];
#pragma unroll
        for (int d0 = 0; d0 < 6; ++d0) asm volatile("" : "=v"(qx[d0]));
        int ring_s0 = 0; bool ring_pre = false;
        const float t0thr = 130.f + bndb;
#define P4_JM(rr) (jmtab[(((F.vcu >> 2) & 1) * 4 + ((rr) & 3)) * 4 + (F.vcu & 3)])
        for (int rep = 0; rep < P4_REPS; ++rep) {
        int t0first = 0;
        { const int bh00 = shared4 ? (F.vcu >> 2) * 4 : (int)blockIdx.x;
          if (bh00 < BATCH * NH) { const int bhp = shared4 ? (bh00 & ~7) + hperm[bh00 & 7] : bh00;
              __syncthreads();
              att::fox_cum<false>(LOGF, bhp >> 3, bhp & 7, (LAS float*)(al + attp::LDS_CUM), (LAS float*)(al + attp::LDS_TMP), F.wave);
              { const int qbf = shared4 ? P4_JM(0) : 0; t0first = attp::fox_t0((LAS const float*)(al + attp::LDS_CUM), qbf * attp::QB, 4 * qbf + 4, t0thr); } } }
        for (int r = 0; r < nrounds; ++r) {
            const int bh0 = shared4 ? (F.vcu >> 2) * 4 + r : (int)blockIdx.x + r * F.G; if (bh0 >= BATCH * NH) break;
            const int bh = shared4 ? (bh0 & ~7) + hperm[bh0 & 7] : bh0;
            const int b = bh >> 3, h = bh & 7, jm = P4_JM(r), nq = shared4 ? 2 : 8, cb = r & 1;
            { const attp::Tensors Tf{QB, nullptr, KB, nullptr, VB, GB, YCAT + 512, 1024}, Tm{QAN, QAR, KAN, KROPE, VA, GA, YCAT, 1024};
              const int bhn0 = shared4 ? bh0 + 1 : bh0 + F.G; const bool more = (r + 1 < nrounds) && (bhn0 < BATCH * NH);
              const int bhn = (shared4 && more) ? (bhn0 & ~7) + hperm[bhn0 & 7] : bhn0;
              int t0cur = t0first;
              for (int iq = 0; iq < nq; ++iq) { const int qb = shared4 ? (iq == 0 ? jm : 7 - jm) : iq; const bool lastq = (iq + 1 == nq);
                  const int iqn = lastq ? 0 : iq + 1, qbn = shared4 ? (iqn == 0 ? jm : 7 - jm) : iqn;
                  const int t0n = lastq ? 0 : attp::fox_t0((LAS const float*)(al + attp::LDS_CUM + cb * 8192), qbn * attp::QB, 4 * qbn + 4, t0thr);
                  ring_s0 = attp::attn_unit<0, 8, true, EARLY>(b, h, qb, Tf, al, F.wave, bndb, ring_s0, ring_pre, lastq ? 1 : 0, wsp, b, h, qbn, qx, t0cur, t0n, cb);
                  t0cur = t0n; ring_pre = true; }
              if (more) {
                  att::fox_cum<true>(LOGF, bhn >> 3, bhn & 7, (LAS float*)(al + attp::LDS_CUM + (cb ^ 1) * 8192), (LAS float*)(al + attp::LDS_TMP), F.wave);
                  { const int qbf = shared4 ? P4_JM(r + 1) : 0; t0first = attp::fox_t0((LAS const float*)(al + attp::LDS_CUM + (cb ^ 1) * 8192), qbf * attp::QB, 4 * qbf + 4, t0thr); } }
              for (int iq = 0; iq < nq; ++iq) { const int qb = shared4 ? (iq == 0 ? jm : 7 - jm) : iq; const bool lastq = (iq + 1 == nq);
                  const int nmode = lastq ? (more ? 0 : -1) : 1; const int bn = lastq ? (bhn >> 3) : b, hn = lastq ? (bhn & 7) : h;
                  const int iqn = lastq ? 0 : iq + 1, qbn = shared4 ? (lastq ? P4_JM(r + 1) : 7 - jm) : iqn;
                  ring_s0 = attp::attn_unit<1, 8, true, EARLY>(b, h, qb, Tm, al, F.wave, bnda, ring_s0, ring_pre, nmode, wsp, bn, hn, qbn, qx, 0, (lastq && more) ? t0first : 0, cb);
                  ring_pre = (nmode >= 0); } }
        }
        }
        if (!EARLY) __builtin_amdgcn_s_setprio(0);
#undef WSP
#undef P4_JM
}

__global__ void __launch_bounds__(NWAVES * 64, 2) mk_fwd(Args args) {
    extern __shared__ __attribute__((aligned(16))) unsigned char lds[];
    Frame F;
    F.lds = (LAS unsigned char*)lds;
    F.wave = __builtin_amdgcn_readfirstlane(threadIdx.x >> 6);
    F.G = gridDim.x; { const int bx = blockIdx.x; F.vcu = (F.G % 8 == 0) ? (bx % 8) * (F.G / 8) + bx / 8 : bx; }
    for (int u = threadIdx.x; u < (LDS_BYTES - LDSCTL_OFF) / 4; u += NWAVES * 64) ((LAS unsigned*)(F.lds + LDSCTL_OFF))[u] = 0u;
    __syncthreads();
    if (N_LAUNCHES == 1 && threadIdx.x == 0) ((gu32*)(args.ws + WSO_CTL))[64 * (F.vcu / P56_GS) + 1 + (F.vcu % P56_GS)] = xb_xcc_id() + 1u;
    if (N_LAUNCHES == 1) (void)xcd_barrier_post((unsigned*)((gu32*)(args.ws + WSO_CTL) + CW_BAR), (volatile LAS unsigned*)(F.lds + MISC_OFF) + 8);
#define GRID_BAR() do { if (N_LAUNCHES == 1) { XcdBarrier b_; b_.bar = (unsigned*)((gu32*)(args.ws + WSO_CTL) + CW_BAR); b_.x = xb_xcc_id(); b_.st = (volatile LAS unsigned*)(F.lds + MISC_OFF) + 8; xcd_barrier(b_); } } while (0)
    const int lo = args.ph_lo, hi = args.ph_hi;
#ifndef PHASE_MASK
#define PHASE_MASK 0x7f
#endif
#define IN(k) (((PHASE_MASK >> (k)) & 1) && lo <= (k) && (k) < hi)
#define BOTH(k) (IN(k) && IN((k) + 1))
#ifndef PROBE_REPEAT
#define PROBE_REPEAT 0
#endif
#define REPS(k) (((PROBE_REPEAT >> (k)) & 1) ? 2 : 1)
    typedef pg8::bf16_t hb;
#define WSP(off) (wsp + (off))
#define PHASE_WS() unsigned long long z_ = 0; asm volatile("" : "+s"(z_)); unsigned char* wsp = args.ws + z_
    if (IN(0)) { for (int rep = 0; rep < REPS(0); ++rep) p0_ada(F, args); if (BOTH(0)) GRID_BAR(); }
    if (IN(1)) { for (int rep = 0; rep < REPS(1); ++rep) { p0_prologue(F, args); p1_xn(F, args); } if (BOTH(1)) GRID_BAR(); }
    if (IN(2)) { PHASE_WS();
      for (int rep = 0; rep < REPS(2); ++rep) {
        pg8::Gemm g{(hb*)WSP(WSO_XN), (hb*)WSP(WSO_WIN), MTOK, NIN, 1024}; pg8::StaticOrder S; S.init(MTOK, NIN, F.G, (int)blockIdx.x, P2_WGM);
        pg8::EpiIn E{wsp};
        pg8::gemm_phase<pg8::EpiIn, pg8::StaticOrder, true, true, 2>(F.lds + RING_OFF, g, S, E, F.wave); }
        if (BOTH(2)) GRID_BAR();
    }
    if (IN(3)) { PHASE_WS();
      for (int rep = 0; rep < REPS(3); ++rep) {
        { pg8::Gemm g{(hb*)WSP(WSO_CQ), (hb*)WSP(WSO_WUQ), MTOK, 768, 384}; pg8::StaticOrder S; S.init(MTOK, 768, F.G, (int)blockIdx.x, 4);
          pg8::EpiQup E{wsp};
          pg8::gemm_phase<pg8::EpiQup, pg8::StaticOrder, true, true>(F.lds + RING_OFF, g, S, E, F.wave); }
        { pg8::Gemm g{(hb*)WSP(WSO_CKV), (hb*)WSP(WSO_WUKV), MTOK, 1024, 256}; pg8::StaticOrder S; S.init(MTOK, 1024, F.G, (int)blockIdx.x, 4);
          pg8::EpiKVup E{wsp};
          pg8::gemm_phase<pg8::EpiKVup, pg8::StaticOrder, true, true>(F.lds + RING_OFF, g, S, E, F.wave); } }
        if (BOTH(3)) GRID_BAR();
    }
    if (IN(4)) { PHASE_WS();
        LAS unsigned char* al = F.lds + RING_OFF; const float* LOGF = (const float*)WSP(WSO_LOGF);
        hb *QB = (hb*)WSP(WSO_QB), *KB = (hb*)WSP(WSO_KB), *VB = (hb*)WSP(WSO_VB), *GB = (hb*)WSP(WSO_GB), *GA = (hb*)WSP(WSO_GA), *QAN = (hb*)WSP(WSO_QAN), *QAR = (hb*)WSP(WSO_QAR), *KAN = (hb*)WSP(WSO_KAN), *KROPE = (hb*)WSP(WSO_KROPE), *VA = (hb*)WSP(WSO_VA), *YCAT = (hb*)WSP(WSO_YCAT);
        const float bndb = ((const float*)WSP(WSO_PAR))[PAR_BNDB], bnda = ((const float*)WSP(WSO_PAR))[PAR_BNDA];
        const bool fastref = ATT_FIXREF && bndb <= 80.f && bnda <= 80.f && (PROBE_FORCE_FALLBACK == 0);
        const bool shared4 = (F.G == 256);
        const int nrounds = shared4 ? 4 : (BATCH * NH + F.G - 1) / F.G;
        if (fastref) {
        LAS int* hperm = (LAS int*)(F.lds + MISC_OFF) + 16;
        if (threadIdx.x == 0) { LAS float* bs = (LAS float*)(F.lds + MISC_OFF) + 24; const float* bfp = (const float*)WSP(WSO_PAR) + PAR_BF; int idx[8];
            for (int i = 0; i < 8; ++i) bs[i] = bfp[i];
            unsigned used = 0u; LAS int* srt = (LAS int*)(F.lds + MISC_OFF) + 32;
            for (int i = 0; i < 8; ++i) { int best = -1; float bv = 0.f; for (int j = 0; j < 8; ++j) if (!((used >> j) & 1u) && (best < 0 || bs[j] < bv)) { best = j; bv = bs[j]; } used |= 1u << best; srt[i] = best; }
            (void)idx; hperm[0] = srt[0]; hperm[1] = srt[3]; hperm[2] = srt[4]; hperm[3] = srt[7]; hperm[4] = srt[1]; hperm[5] = srt[2]; hperm[6] = srt[5]; hperm[7] = srt[6];
            LAS int* jt = (LAS int*)(F.lds + MISC_OFF) + 40; LAS float* ld = (LAS float*)(F.lds + MISC_OFF) + 72; LAS int* ord = (LAS int*)(F.lds + MISC_OFF) + 76;
            const float thr_ = 130.f + bndb;
            for (int st = 0; st < 2; ++st) { for (int j = 0; j < 4; ++j) ld[j] = 0.f;
                for (int r = 0; r < 4; ++r) { const float bb = bs[hperm[st * 4 + r]];
                    const float d = __log2f(1.f + __expf(-bb)); float W = (d > 1e-6f) ? thr_ / (64.f * d) : 64.f; if (W > 64.f) W = 64.f;
                    unsigned usd = 0u;
                    for (int k = 0; k < 4; ++k) { int best = -1; float bv = 0.f; for (int j = 0; j < 4; ++j) if (!((usd >> j) & 1u) && (best < 0 || ld[j] > bv)) { best = j; bv = ld[j]; } usd |= 1u << best; ord[k] = best; }
                    for (int k = 0; k < 4; ++k) { const int j = ord[k]; const float c0 = fminf(4.f * k + 4.f, W + 5.f), c1 = fminf(4.f * (7 - k) + 4.f, W + 5.f);
                        jt[(st * 4 + r) * 4 + j] = k; ld[j] += c0 + c1; } } } }
        __syncthreads();
        if (F.wave < 4) p4_fast<true>(F, wsp, bndb, bnda, shared4, nrounds); else p4_fast<false>(F, wsp, bndb, bnda, shared4, nrounds);
        } else {
        for (int r = 0; r < nrounds; ++r) {
            const int bh = shared4 ? (F.vcu >> 2) * 4 + r : (int)blockIdx.x + r * F.G; if (bh >= BATCH * NH) break;
            const int b = bh >> 3, h = bh & 7, jm = F.vcu & 3, nq = shared4 ? 2 : 8;
            __syncthreads();
            att::fox_cum<false>(LOGF, b, h, (LAS float*)(al + att::LDS_CUM), (LAS float*)(al + att::LDS_TMP), F.wave);
            const att::Tensors Tf{QB, nullptr, KB, nullptr, VB, GB, YCAT + 512, 1024}, Tm{QAN, QAR, KAN, KROPE, VA, GA, YCAT, 1024};
            for (int iq = 0; iq < nq; ++iq) { const int qb = shared4 ? (iq == 0 ? jm : 7 - jm) : iq; att::attn_unit<0>(b, h, qb, Tf, al, F.wave); }
            for (int iq = 0; iq < nq; ++iq) { const int qb = shared4 ? (iq == 0 ? jm : 7 - jm) : iq; att::attn_unit<1>(b, h, qb, Tm, al, F.wave); }
        }
        }
        if (BOTH(4)) GRID_BAR();
    }
    const bool grouped = (N_LAUNCHES == 1) && (F.G == 256);
    if (IN(5)) { PHASE_WS();
      for (int rep = 0; rep < REPS(5); ++rep) {
        pg8::Gemm g{(hb*)WSP(WSO_YCAT), (hb*)WSP(WSO_WCAT), MTOK, 1024, 1024};
        pg8::EpiMerge E{wsp};
        if (grouped) { pg8::GroupOrder<P56_GS> S; S.init(F.vcu); pg8::gemm_phase<pg8::EpiMerge, pg8::GroupOrder<P56_GS>, true, true>(F.lds + RING_OFF, g, S, E, F.wave); }
        else { pg8::PanelOrder S; S.init(MTOK, 1024, F.G, (int)blockIdx.x); pg8::gemm_phase<pg8::EpiMerge, pg8::PanelOrder, true, true>(F.lds + RING_OFF, g, S, E, F.wave); } }
        if (grouped) group_barrier<P56_GS>((unsigned*)((gu32*)(args.ws + WSO_CTL)), (unsigned*)((gu32*)(args.ws + WSO_CTL) + CW_BAR), F.vcu);
        else {
        asm volatile("s_waitcnt vmcnt(0)" ::: "memory"); __syncthreads();
        if (threadIdx.x == 0) { __builtin_amdgcn_fence(__ATOMIC_ACQUIRE, "agent"); asm volatile("s_waitcnt vmcnt(0)" ::: "memory"); }
        __syncthreads(); }
    }
    if (IN(6)) { PHASE_WS();
      for (int rep = 0; rep < REPS(6); ++rep) {
        pg8::Gemm g{(hb*)WSP(WSO_MERGED), (hb*)WSP(WSO_WOUT), MTOK, 1024, 1024};
        pg8::EpiOut E{args.in[0], args.out, (const float*)WSP(WSO_ADA) + 2048};
        if (grouped) { pg8::GroupOrder<P56_GS> S; S.init(F.vcu); pg8::gemm_phase<pg8::EpiOut, pg8::GroupOrder<P56_GS>, true, true>(F.lds + RING_OFF, g, S, E, F.wave); }
        else { pg8::PanelOrder S; S.init(MTOK, 1024, F.G, (int)blockIdx.x); pg8::gemm_phase<pg8::EpiOut, pg8::PanelOrder, true, true>(F.lds + RING_OFF, g, S, E, F.wave); } }
    }
#undef IN
#undef BOTH
}

extern "C" void kernel_launch(void* const* d_in, const int* in_sizes, int n_in, void* d_out, int out_size, void* d_ws, size_t ws_size, hipStream_t stream) {
    static int grid = 0;
    if (grid == 0) {
        if (n_in != 21 || in_sizes[0] != MTOK * DMODEL || out_size != MTOK * DMODEL || ws_size < WSO_END) { fprintf(stderr, "kernel_launch: unexpected shapes: n_in %d in0 %d out %d ws %zu (need %zu)\n", n_in, n_in > 0 ? in_sizes[0] : -1, out_size, ws_size, (size_t)WSO_END); grid = -1; return; }
        int dev = 0, cus = 0, per_cu = 0;
        if (hipGetDevice(&dev) != hipSuccess || hipDeviceGetAttribute(&cus, hipDeviceAttributeMultiprocessorCount, dev) != hipSuccess) { fprintf(stderr, "kernel_launch: device query failed\n"); grid = -1; return; }
        if (hipFuncSetAttribute((const void*)mk_fwd, hipFuncAttributeMaxDynamicSharedMemorySize, LDS_BYTES) != hipSuccess) { fprintf(stderr, "kernel_launch: hipFuncSetAttribute failed\n"); grid = -1; return; }
        if (hipOccupancyMaxActiveBlocksPerMultiprocessor(&per_cu, (const void*)mk_fwd, NWAVES * 64, LDS_BYTES) != hipSuccess || per_cu < 1) fprintf(stderr, "kernel_launch: note: occupancy query reports %d workgroups per CU\n", per_cu);
        (void)hipGetLastError();
        grid = cus;
    }
    if (grid < 0) return;
    if (hipMemsetAsync((char*)d_ws + WSO_CTL, 0, CTL_ZERO_BYTES, stream) != hipSuccess) { fprintf(stderr, "kernel_launch: memset failed\n"); return; }
    Args a{};
    for (int i = 0; i < 21; ++i) a.in[i] = (const float*)d_in[i];
    a.out = (float*)d_out; a.ws = (unsigned char*)d_ws;
    for (int li = 0; li < N_LAUNCHES; ++li) {
        a.ph_lo = (N_LAUNCHES == 1) ? 0 : li; a.ph_hi = (N_LAUNCHES == 1) ? N_PHASES : li + 1; a.li = li;
        hipLaunchKernelGGL(mk_fwd, dim3(grid), dim3(NWAVES * 64), LDS_BYTES, stream, a);
        const hipError_t le = hipPeekAtLastError();
        if (le != hipSuccess) { fprintf(stderr, "kernel_launch: launch %d failed: %s\n", li, hipGetErrorName(le)); break; }
    }
}
```
